# Optimizing an MI355X kernel written in HIP

```python
import jax, jax.numpy as jnp
from jax import lax
import numpy as np

D_MODEL = 1024
BATCH = 16
SEQ = 4096
DEPTH = 1
DEC_BATCH = 8
DEC_SEQ = 16
PAST_LEN = 4096

CHUNK = 64
N_ATT_HEADS = 8
HEAD_DIM = 64
ATT_DIM = N_ATT_HEADS * HEAD_DIM
N_CONV_GROUPS = 8
CONV_DIM = N_CONV_GROUPS * HEAD_DIM
CONV_WIDTH = 3
D_FF = 4 * D_MODEL
Q_BLOCK = 128
NORM_EPS = 1e-6
PROJ_DIM = 3 * ATT_DIM + N_ATT_HEADS + 3 * CONV_DIM
ATT_SCALE = HEAD_DIM ** -0.5

kernel_name = 'hymba_fox_shortconv_streaming_step'


def rmsnorm(x, g):
    xf = x.astype(jnp.float32)
    y = xf * lax.rsqrt(jnp.mean(xf * xf, axis=-1, keepdims=True) + NORM_EPS)
    return (y * g.astype(jnp.float32)).astype(x.dtype)


def modulate(h, shift, scale):
    return h * (1 + scale[:, None, :]) + shift[:, None, :]


def to_heads(t):
    return t.reshape(t.shape[:-1] + (N_ATT_HEADS, HEAD_DIM))


def mix_inputs(h, w_in, b_f):
    p = h @ w_in
    cuts = [ATT_DIM, 2 * ATT_DIM, 3 * ATT_DIM, 3 * ATT_DIM + N_ATT_HEADS,
            3 * ATT_DIM + N_ATT_HEADS + CONV_DIM, 3 * ATT_DIM + N_ATT_HEADS + 2 * CONV_DIM]
    q, k, v, fl, bg, cg, u = jnp.split(p, cuts, axis=-1)
    logf = jax.nn.log_sigmoid(fl.astype(jnp.float32) + b_f.astype(jnp.float32))
    return to_heads(q), to_heads(k), to_heads(v), logf, bg, cg * u


def fox_prompt(q, k, v, logf):
    B, S = q.shape[0], q.shape[1]
    nb = S // Q_BLOCK
    F = jnp.cumsum(logf, axis=1)
    Fk = F.transpose(0, 2, 1)[:, :, None, :]
    qb = q.reshape(B, nb, Q_BLOCK, N_ATT_HEADS, HEAD_DIM).transpose(1, 0, 2, 3, 4)
    Fqb = F.reshape(B, nb, Q_BLOCK, N_ATT_HEADS).transpose(1, 0, 3, 2)
    kpos = jnp.arange(S)

    def block(args):
        qi, fqi, bi = args
        s = jnp.einsum('bqhd,bkhd->bhqk', qi, k, preferred_element_type=jnp.float32) * ATT_SCALE
        s = s + fqi[..., None] - Fk
        qpos = bi * Q_BLOCK + jnp.arange(Q_BLOCK)
        s = jnp.where(kpos[None, :] <= qpos[:, None], s, -jnp.inf)
        p = jax.nn.softmax(s, axis=-1)
        return jnp.einsum('bhqk,bkhd->bqhd', p.astype(v.dtype), v)

    o = lax.map(block, (qb, Fqb, jnp.arange(nb)))
    return o.transpose(1, 0, 2, 3, 4).reshape(B, S, ATT_DIM)


def fox_sample(q, k, v, logf, ck, cv, clogf):
    B, T = q.shape[0], q.shape[1]
    P = ck.shape[1]
    k_all = jnp.concatenate([ck.astype(k.dtype), k], axis=1)
    v_all = jnp.concatenate([cv.astype(v.dtype), v], axis=1)
    F = jnp.cumsum(jnp.concatenate([clogf.astype(jnp.float32), logf], axis=1), axis=1)
    Fq = F[:, P:].transpose(0, 2, 1)[..., None]
    Fk = F.transpose(0, 2, 1)[:, :, None, :]
    s = jnp.einsum('bqhd,bkhd->bhqk', q, k_all, preferred_element_type=jnp.float32) * ATT_SCALE
    s = s + Fq - Fk
    mask = jnp.arange(P + T)[None, :] <= (P + jnp.arange(T))[:, None]
    s = jnp.where(mask, s, -jnp.inf)
    p = jax.nn.softmax(s, axis=-1)
    o = jnp.einsum('bhqk,bkhd->bqhd', p.astype(v_all.dtype), v_all)
    return o.reshape(B, T, ATT_DIM)


def short_conv(u, prev, w_conv):
    ue = jnp.concatenate([prev.astype(u.dtype), u], axis=1)
    y = lax.conv_general_dilated(ue, w_conv[:, None, :].astype(u.dtype), window_strides=(1,),
                                 padding='VALID', dimension_numbers=('NWC', 'WIO', 'NWC'),
                                 feature_group_count=CONV_DIM)
    return y, ue[:, -(CONV_WIDTH - 1):]


def run_layer(x, c, w_ada, b_ada, g1, g2, w_in, b_f, w_conv, g_att, g_conv, w_out, w_up, w_down,
              attend, conv_prev):
    sh1, sc1, gt1, sh2, sc2, gt2 = jnp.split(jax.nn.silu(c) @ w_ada + b_ada, 6, axis=-1)
    h = modulate(rmsnorm(x, g1), sh1, sc1)
    q, k, v, logf, bg, u = mix_inputs(h, w_in, b_f)
    att = attend(q, k, v, logf)
    cv, conv_state = short_conv(u, conv_prev, w_conv)
    merged = jnp.concatenate([rmsnorm(att, g_att), rmsnorm(bg * cv, g_conv)], axis=-1)
    x = x + gt1[:, None, :] * (merged @ w_out)
    h = modulate(rmsnorm(x, g2), sh2, sc2)
    x = x + gt2[:, None, :] * (jnp.square(jax.nn.relu(h @ w_up)) @ w_down)
    return x, k, v, logf, conv_state


def setup_inputs(seed: int = 0) -> dict:
    key = jax.random.key(seed)
    ks = jax.random.split(key, 24)

    def nrm(k, shape, scale=1.0):
        return jax.random.normal(k, shape, jnp.float32) * scale

    return {
        'x_prompt': nrm(ks[0], (BATCH, SEQ, D_MODEL)),
        'x_sample': nrm(ks[1], (DEC_BATCH, DEC_SEQ, D_MODEL)),
        'cache_k': nrm(ks[2], (DEPTH, DEC_BATCH, PAST_LEN, N_ATT_HEADS, HEAD_DIM)),
        'cache_v': nrm(ks[3], (DEPTH, DEC_BATCH, PAST_LEN, N_ATT_HEADS, HEAD_DIM)),
        'cache_logf': jax.nn.log_sigmoid(3.0 + nrm(ks[4], (DEPTH, DEC_BATCH, PAST_LEN, N_ATT_HEADS))),
        'cache_conv': nrm(ks[5], (DEPTH, DEC_BATCH, CONV_WIDTH - 1, CONV_DIM), 0.5),
        'c_prompt': nrm(ks[6], (BATCH, D_MODEL)),
        'c_sample': nrm(ks[7], (DEC_BATCH, D_MODEL)),
        'w_ada': nrm(ks[8], (DEPTH, D_MODEL, 6 * D_MODEL), 0.2 * D_MODEL ** -0.5),
        'b_ada': nrm(ks[9], (DEPTH, 6 * D_MODEL), 0.01),
        'g_norm1': 1.0 + nrm(ks[10], (DEPTH, D_MODEL), 0.05),
        'g_norm2': 1.0 + nrm(ks[11], (DEPTH, D_MODEL), 0.05),
        'w_in': nrm(ks[12], (DEPTH, D_MODEL, PROJ_DIM), D_MODEL ** -0.5),
        'b_f': 3.0 + nrm(ks[13], (DEPTH, N_ATT_HEADS), 0.5),
        'w_conv': nrm(ks[14], (DEPTH, CONV_WIDTH, CONV_DIM), CONV_WIDTH ** -0.5),
        'g_attn_out': 1.0 + nrm(ks[15], (DEPTH, ATT_DIM), 0.05),
        'g_conv_out': 1.0 + nrm(ks[16], (DEPTH, CONV_DIM), 0.05),
        'w_out': nrm(ks[17], (DEPTH, D_MODEL, D_MODEL), D_MODEL ** -0.5),
        'w_up': nrm(ks[18], (DEPTH, D_MODEL, D_FF), D_MODEL ** -0.5),
        'w_down': nrm(ks[19], (DEPTH, D_FF, D_MODEL), D_FF ** -0.5),
        'w_ada_final': nrm(ks[20], (D_MODEL, 2 * D_MODEL), 0.2 * D_MODEL ** -0.5),
        'b_ada_final': nrm(ks[21], (2 * D_MODEL,), 0.01),
        'g_final': 1.0 + nrm(ks[22], (D_MODEL,), 0.05),
    }


def reference(x_prompt, x_sample, cache_k, cache_v, cache_logf, cache_conv, c_prompt, c_sample,
              w_ada, b_ada, g_norm1, g_norm2, w_in, b_f, w_conv, g_attn_out, g_conv_out, w_out,
              w_up, w_down, w_ada_final, b_ada_final, g_final):
    xp, xs = x_prompt, x_sample
    kp, vp, lp, cp = [], [], [], []
    ksl, vsl, lsl, csl = [], [], [], []
    for l in range(DEPTH):
        lw = (w_ada[l], b_ada[l], g_norm1[l], g_norm2[l], w_in[l], b_f[l], w_conv[l],
              g_attn_out[l], g_conv_out[l], w_out[l], w_up[l], w_down[l])
        prev0 = jnp.zeros((xp.shape[0], CONV_WIDTH - 1, CONV_DIM), xp.dtype)
        xp, k1, v1, f1, s1 = run_layer(xp, c_prompt, *lw, fox_prompt, prev0)
        ck, cv, cf = cache_k[l], cache_v[l], cache_logf[l]
        attend_s = lambda q, k, v, f, ck=ck, cv=cv, cf=cf: fox_sample(q, k, v, f, ck, cv, cf)
        xs, k2, v2, f2, s2 = run_layer(xs, c_sample, *lw, attend_s, cache_conv[l])
        kp.append(k1); vp.append(v1); lp.append(f1); cp.append(s1)
        ksl.append(k2); vsl.append(v2); lsl.append(f2); csl.append(s2)

    def final(x, c):
        sh, sc = jnp.split(jax.nn.silu(c) @ w_ada_final + b_ada_final, 2, axis=-1)
        return modulate(rmsnorm(x, g_final), sh, sc)

    y_prompt = final(xp, c_prompt)
    y_sample = final(xs, c_sample)
    return (y_prompt, y_sample,
            jnp.stack(kp), jnp.stack(vp), jnp.stack(lp), jnp.stack(cp),
            jnp.stack(ksl), jnp.stack(vsl), jnp.stack(lsl), jnp.stack(csl))
```

```cpp
#include <hip/hip_runtime.h>
#include <hip/hip_cooperative_groups.h>
#include <cstdio>
#include <cstdint>
#include <cmath>
namespace cg = cooperative_groups;

constexpr int MP = 65536;
constexpr int MS = 128;
constexpr int MPAD = 65792;
constexpr int DMODEL = 1024, FFD = 4096, NIN = 3072, PROJ = 3080;
constexpr float NORM_EPS = 1e-6f;
constexpr float LOG2E = 1.4426950408889634f;
constexpr float QSCALE = 0.125f * 1.4426950408889634f;
constexpr size_t O_YP = 0, O_YS = 67108864, O_KP = 67239936, O_VP = 100794368, O_LP = 134348800, O_CP = 134873088,
                 O_KS = 134889472, O_VS = 134955008, O_LS = 135020544, O_CS = 135021568;
constexpr size_t MiB = 1u << 20;
constexpr size_t WS_WIN = 0, WS_WOUT = 6 * MiB, WS_WUP = 8 * MiB, WS_WDN = 16 * MiB;
constexpr size_t WS_MOD = 24 * MiB, WS_MODF = 24 * MiB + 640 * 1024, WS_GM2 = 24 * MiB + 896 * 1024, WS_BU = 25 * MiB;
constexpr size_t WS_FS = 26 * MiB, WS_FSS = 28 * MiB, WS_PART = 30 * MiB, WS_SS = 32 * MiB;
constexpr size_t WS_R1 = 40 * MiB;
constexpr size_t R1_XN = WS_R1, R1_Q = WS_R1 + (size_t)MPAD * 2048;
constexpr size_t BUF512 = (size_t)MPAD * 512;
constexpr size_t WS_X1 = WS_R1 + 514 * MiB;
constexpr size_t WS_A2 = WS_X1 + 257 * MiB;
constexpr size_t WS_END = WS_A2 + 129 * MiB;
static_assert((size_t)MPAD * 8192 == 514 * MiB, "H size");

namespace pg8 {
#define PG8_LAS __attribute__((address_space(3)))
typedef unsigned short bf16_t;
typedef short bf16x8 __attribute__((ext_vector_type(8)));
typedef float f32x4 __attribute__((ext_vector_type(4)));
typedef unsigned u32x4 __attribute__((ext_vector_type(4)));
constexpr int BM = 256, BK = 64, HALF = 128, HTB = HALF * BK * 2  , STAGE_BYTES = 8 * HTB, NXCD = 8, WGM = 8;

__host__ __device__ __forceinline__ int lds_byte(int r, int c) { const int st = (r >> 4) * 2 + (c >> 5), rr = r & 15, cc = c & 31, ob = rr * 64 + cc * 2; return st * 1024 + (ob ^ (((ob >> 9) & 1) << 5)); }
__host__ __device__ __forceinline__ void stage_rc(int b, int& R, int& C) { const int st = b / 1024, sb = b % 1024, swz = sb ^ (((sb >> 9) & 1) << 5); R = (st >> 1) * 16 + swz / 64; C = (st & 1) * 32 + (swz % 64) / 2; }
__host__ __device__ __forceinline__ int perm32(int rho) { const int n = rho >> 4, i = rho & 15; return 8 * (i >> 2) + 4 * n + (i & 3); }

struct Unit { int pm, pn; };
struct Gemm { const bf16_t* A; const bf16_t* Bt; int M, N, K; };

struct StaticOrder {
    int nM, nN, nwg, G, c;
    __host__ __device__ void init(int M, int N, int G_, int c_) { nM = M / BM; nN = N / BM; nwg = nM * nN; G = G_; c = c_; }
    __host__ __device__ bool next(int i, Unit& u) const {
        const long L = (long)i * G + c; if (L >= nwg) return false;
        int wgid = (int)L; { const int q = nwg / NXCD, r = nwg % NXCD, xcd = wgid % NXCD, off = wgid / NXCD; wgid = (xcd < r ? xcd * (q + 1) : r * (q + 1) + (xcd - r) * q) + off; }
        const int nig = WGM * nN, gid = wgid / nig, fm = gid * WGM, gsz = (nM - fm) < WGM ? (nM - fm) : WGM;
        u.pm = fm + ((wgid % nig) % gsz); u.pn = (wgid % nig) / gsz; return true;
    }
    __device__ __forceinline__ void a_ready(const Unit&) const {}
    __device__ __forceinline__ void done(const Unit&) const {}
};

__device__ __forceinline__ unsigned cvt_pk_bf16(float lo, float hi) { unsigned r; asm volatile("v_cvt_pk_bf16_f32 %0, %1, %2" : "=v"(r) : "v"(lo), "v"(hi)); return r; }
typedef float f32x2 __attribute__((ext_vector_type(2)));
__device__ __forceinline__ u32x4 pack8(const f32x4 v0, const f32x4 v1) { u32x4 w; w.x = cvt_pk_bf16(v0[0], v0[1]); w.y = cvt_pk_bf16(v0[2], v0[3]); w.z = cvt_pk_bf16(v1[0], v1[1]); w.w = cvt_pk_bf16(v1[2], v1[3]); return w; }
__device__ __forceinline__ float sumsq4(const f32x4 v) { return (v[0] * v[0] + v[1] * v[1]) + (v[2] * v[2] + v[3] * v[3]); }

struct EpiIn {
    static constexpr bool PERM = true, AFTER_DRAIN = false;
    bf16_t* QB; float* out;
    __device__ __forceinline__ void operator()(const f32x4 (&acc)[2][2][4][2], const Unit& u, int wr, int wc, int fr, int fq) const {
        const int t = u.pn >> 1;
        bf16_t* base = QB + (size_t)t * BUF512;
        const int col0 = (u.pn & 1) * 256 + wc * 32 + 8 * fq;
        const float sc = (t == 0) ? QSCALE : 1.f;
        const bool kv = (t == 1 || t == 2);
        float* fp = out + (t == 1 ? O_KP : O_VP); float* fs = out + (t == 1 ? O_KS : O_VS);
        const int row0 = u.pm * BM + wr * 64 + fr;
#pragma unroll
        for (int ai = 0; ai < 2; ++ai)
#pragma unroll
            for (int m = 0; m < 4; ++m) {
                const int row = row0 + ai * HALF + m * 16;
                bf16_t* rowp = base + (size_t)row * 512 + col0;
                float* fo = nullptr;
                if (kv) { if (row < MP) fo = fp + (size_t)row * 512 + col0; else if (row < MP + MS) fo = fs + (size_t)(row - MP) * 512 + col0; }
#pragma unroll
                for (int bj = 0; bj < 2; ++bj) {
                    const f32x4 v0 = acc[ai][bj][m][0] * sc, v1 = acc[ai][bj][m][1] * sc;
                    *(u32x4*)(rowp + bj * HALF) = pack8(v0, v1);
                    if (fo) { *(f32x4*)(fo + bj * HALF) = v0; *(f32x4*)(fo + bj * HALF + 4) = v1; }
                }
            }
    }
};
struct EpiOut {
    static constexpr bool PERM = true, AFTER_DRAIN = false;
    const float* xp; const float* xs; const float* mod; const float* gm2; float* X1; bf16_t* A2; float* SS;
    __device__ __forceinline__ void operator()(const f32x4 (&acc)[2][2][4][2], const Unit& u, int wr, int wc, int fr, int fq) const {
        const int col0 = u.pn * BM + wc * 32 + 8 * fq;
        const int row0 = u.pm * BM + wr * 64 + fr;
#pragma unroll
        for (int ai = 0; ai < 2; ++ai) {
            if (u.pm == 256 && ai == 1) continue;
#pragma unroll
            for (int m = 0; m < 4; ++m) {
                const int row = row0 + ai * HALF + m * 16;
                const int mr = (u.pm < 256) ? (u.pm >> 4) : 16 + 4 * wr + m;
                const float* xr = (row < MP) ? xp + (size_t)row * 1024 : xs + (size_t)(row - MP) * 1024;
                const float* gt = mod + (size_t)mr * 6144 + 2048; const float* gm = gm2 + (size_t)mr * 1024;
                float s = 0.f;
#pragma unroll
                for (int bj = 0; bj < 2; ++bj) {
                    const int c = col0 + bj * HALF;
                    const f32x4 xa = *(const f32x4*)(xr + c), xb = *(const f32x4*)(xr + c + 4);
                    const f32x4 ga = *(const f32x4*)(gt + c), gb = *(const f32x4*)(gt + c + 4);
                    const f32x4 ma = *(const f32x4*)(gm + c), mb = *(const f32x4*)(gm + c + 4);
                    const f32x4 r0 = xa + ga * acc[ai][bj][m][0], r1 = xb + gb * acc[ai][bj][m][1];
                    *(f32x4*)(X1 + (size_t)row * 1024 + c) = r0; *(f32x4*)(X1 + (size_t)row * 1024 + c + 4) = r1;
                    s += sumsq4(r0) + sumsq4(r1);
                    *(u32x4*)(A2 + (size_t)row * 1024 + c) = pack8(r0 * ma, r1 * mb);
                }
                s += __shfl_xor(s, 16); s += __shfl_xor(s, 32);
                if (fq == 0) SS[(size_t)row * 16 + u.pn * 4 + wc] = s;
            }
        }
    }
};
struct EpiUp {
    static constexpr bool PERM = true, AFTER_DRAIN = false;
    const float* SS; const float* BU; bf16_t* H;
    __device__ __forceinline__ void operator()(const f32x4 (&acc)[2][2][4][2], const Unit& u, int wr, int wc, int fr, int fq) const {
        const int col0 = u.pn * BM + wc * 32 + 8 * fq;
        const int row0 = u.pm * BM + wr * 64 + fr;
#pragma unroll
        for (int ai = 0; ai < 2; ++ai)
#pragma unroll
            for (int m = 0; m < 4; ++m) {
                const int row = row0 + ai * HALF + m * 16;
                const int mr = (u.pm < 256) ? (u.pm >> 4) : (ai == 0 ? 16 + 4 * wr + m : 16);
                const f32x4* sp = (const f32x4*)(SS + (size_t)row * 16);
                const f32x4 s4 = (sp[0] + sp[1]) + (sp[2] + sp[3]);
                const float rstd = 1.0f / sqrtf(((s4[0] + s4[1]) + (s4[2] + s4[3])) * (1.0f / 1024.0f) + NORM_EPS);
                const float* bu = BU + (size_t)mr * 4096;
#pragma unroll
                for (int bj = 0; bj < 2; ++bj) {
                    const int c = col0 + bj * HALF;
                    const f32x4 b0 = *(const f32x4*)(bu + c), b1 = *(const f32x4*)(bu + c + 4);
                    f32x4 v0 = acc[ai][bj][m][0] * rstd + b0, v1 = acc[ai][bj][m][1] * rstd + b1;
#pragma unroll
                    for (int j = 0; j < 4; ++j) { const float a = fmaxf(v0[j], 0.f), b = fmaxf(v1[j], 0.f); v0[j] = a * a; v1[j] = b * b; }
                    *(u32x4*)(H + (size_t)row * 4096 + c) = pack8(v0, v1);
                }
            }
    }
};
struct EpiDown {
    static constexpr bool PERM = true, AFTER_DRAIN = false;
    const float* mod; float* X1;
    __device__ __forceinline__ void operator()(const f32x4 (&acc)[2][2][4][2], const Unit& u, int wr, int wc, int fr, int fq) const {
        const int col0 = u.pn * BM + wc * 32 + 8 * fq;
        const int row0 = u.pm * BM + wr * 64 + fr;
#pragma unroll
        for (int ai = 0; ai < 2; ++ai) {
            if (u.pm == 256 && ai == 1) continue;
#pragma unroll
            for (int m = 0; m < 4; ++m) {
                const int row = row0 + ai * HALF + m * 16;
                const int mr = (u.pm < 256) ? (u.pm >> 4) : 16 + 4 * wr + m;
                const float* gt = mod + (size_t)mr * 6144 + 5120;
                float* xr = X1 + (size_t)row * 1024;
#pragma unroll
                for (int bj = 0; bj < 2; ++bj) {
                    const int c = col0 + bj * HALF;
                    const f32x4 xa = *(const f32x4*)(xr + c), xb = *(const f32x4*)(xr + c + 4);
                    const f32x4 ga = *(const f32x4*)(gt + c), gb = *(const f32x4*)(gt + c + 4);
                    *(f32x4*)(xr + c) = xa + ga * acc[ai][bj][m][0]; *(f32x4*)(xr + c + 4) = xb + gb * acc[ai][bj][m][1];
                }
            }
        }
    }
};

template <class Epi, class Sched, bool ALIGN_EPI = false, bool SP2 = false>
__device__ __forceinline__ void gemm_phase(PG8_LAS unsigned char* lds, const Gemm g, const Sched& S, const Epi& E) {
    const int tid = threadIdx.x, wid = __builtin_amdgcn_readfirstlane(tid >> 6), lane = tid & 63, wr = wid >> 2, wc = wid & 3, fr = lane & 15, fq = lane >> 4;
    const int K = g.K, nt = K / BK;
    unsigned voffA[2], voffB[2];
#pragma unroll
    for (int i = 0; i < 2; ++i) { int R, C; stage_rc(tid * 16 + i * 8192, R, C); const int Rb = Epi::PERM ? ((R & ~31) + perm32(R & 31)) : R;
        voffA[i] = (unsigned)(R * K + C) * 2u; voffB[i] = (unsigned)(Rb * K + C) * 2u; }
    const size_t kstep = (size_t)(BK * 2);
    const size_t hstep = (size_t)HALF * K * 2;
    const size_t tstep = 2 * hstep;
    const unsigned ldsw = (unsigned)wid * 1024u;
    const int aoff = lds_byte(wr * 64 + fr, fq * 8), boff = lds_byte(wc * 32 + fr, fq * 8);
#define PG8_SA(b, h) (((b) * 2 + (h)) * HTB)
#define PG8_SB(b, h) ((4 + (b) * 2 + (h)) * HTB)
#define PG8_STAGE(bufoff, gbase, voff) do { _Pragma("unroll") for (int _i = 0; _i < 2; ++_i) \
        __builtin_amdgcn_global_load_lds((const unsigned*)((const char*)(gbase) + (voff)[_i]), (PG8_LAS unsigned*)(lds + (bufoff) + ldsw + _i * 8192), 16, 0, 0); } while (0)
#define PG8_LDA(dst, b, h) do { _Pragma("unroll") for (int m = 0; m < 4; ++m) _Pragma("unroll") for (int k = 0; k < 2; ++k) dst[m][k] = *(const PG8_LAS bf16x8*)(lds + PG8_SA(b, h) + aoff + m * 2048 + k * 1024); } while (0)
#define PG8_LDB(dst, b, h) do { _Pragma("unroll") for (int n = 0; n < 2; ++n) _Pragma("unroll") for (int k = 0; k < 2; ++k) dst[n][k] = *(const PG8_LAS bf16x8*)(lds + PG8_SB(b, h) + boff + n * 2048 + k * 1024); } while (0)
#define PG8_MMA(ai, bj, At, Bt) do { __builtin_amdgcn_s_setprio(1); _Pragma("unroll") for (int m = 0; m < 4; ++m) _Pragma("unroll") for (int n = 0; n < 2; ++n) _Pragma("unroll") for (int k = 0; k < 2; ++k) \
        acc[ai][bj][m][n] = __builtin_amdgcn_mfma_f32_16x16x32_bf16(Bt[n][k], At[m][k], acc[ai][bj][m][n], 0, 0, 0); __builtin_amdgcn_s_setprio(0); } while (0)
#define PG8_WAIT_V(n) asm volatile("s_waitcnt vmcnt(" #n ")" ::: "memory")
#define PG8_WAIT_L(n) asm volatile("s_waitcnt lgkmcnt(" #n ")" ::: "memory")
#define PG8_BAR __builtin_amdgcn_s_barrier()
#define PG8_SCHED __builtin_amdgcn_sched_barrier(0)
    Unit cur, nxt; int ui = 0;
    if (!S.next(0, cur)) return;
    f32x4 acc[2][2][4][2];
#pragma unroll
    for (int a = 0; a < 2; ++a)
#pragma unroll
        for (int b = 0; b < 2; ++b)
#pragma unroll
            for (int m = 0; m < 4; ++m)
#pragma unroll
                for (int n = 0; n < 2; ++n) acc[a][b][m][n] = (f32x4){0.f, 0.f, 0.f, 0.f};
    bf16x8 At[4][2], B0[2][2], B1[2][2];
    const char* cA = (const char*)g.A + (size_t)cur.pm * tstep; const char* cB = (const char*)g.Bt + (size_t)cur.pn * tstep;
    S.a_ready(cur);
    if constexpr (SP2) {
        PG8_STAGE(PG8_SB(0, 0), cB, voffB); PG8_STAGE(PG8_SB(0, 1), cB + hstep, voffB); PG8_STAGE(PG8_SA(0, 0), cA, voffA); PG8_STAGE(PG8_SA(0, 1), cA + hstep, voffA);
        if (wr == 1) PG8_BAR;
        PG8_WAIT_V(2); PG8_BAR;
        PG8_STAGE(PG8_SB(1, 0), cB + kstep, voffB); PG8_STAGE(PG8_SA(1, 0), cA + kstep, voffA); PG8_STAGE(PG8_SB(1, 1), cB + hstep + kstep, voffB);
        PG8_WAIT_V(6); PG8_BAR;
    } else {
        PG8_STAGE(PG8_SB(0, 0), cB, voffB); PG8_STAGE(PG8_SA(0, 0), cA, voffA); PG8_STAGE(PG8_SB(0, 1), cB + hstep, voffB); PG8_STAGE(PG8_SA(0, 1), cA + hstep, voffA);
        if (wr == 1) PG8_BAR;
        PG8_WAIT_V(4); PG8_BAR;
        PG8_STAGE(PG8_SB(1, 0), cB + kstep, voffB); PG8_STAGE(PG8_SA(1, 0), cA + kstep, voffA); PG8_STAGE(PG8_SB(1, 1), cB + hstep + kstep, voffB);
        PG8_WAIT_V(6); PG8_BAR;
    }
    for (;;) {
        const bool has_next = S.next(ui + 1, nxt);
        const char* nA = has_next ? (const char*)g.A + (size_t)nxt.pm * tstep : cA; const char* nB = has_next ? (const char*)g.Bt + (size_t)nxt.pn * tstep : cB;
        for (int t = 0; t < nt; t += 2) {
            const bool last = (t == nt - 2);
            const char* a1 = cA + (size_t)(t + 1) * kstep;
            const char* a2 = last ? nA : cA + (size_t)(t + 2) * kstep; const char* b2 = last ? nB : cB + (size_t)(t + 2) * kstep;
            const char* a3 = a2 + kstep; const char* b3 = b2 + kstep;
            if (last && has_next) S.a_ready(nxt);
            if constexpr (SP2) {
            PG8_LDB(B0, 0, 0); PG8_LDB(B1, 0, 1); PG8_SCHED; PG8_LDA(At, 0, 0); PG8_STAGE(PG8_SA(1, 1), a1 + hstep, voffA);
            PG8_WAIT_V(8); PG8_WAIT_L(0); PG8_BAR; PG8_MMA(0, 0, At, B0); PG8_MMA(0, 1, At, B1); PG8_BAR; PG8_SCHED;
            PG8_LDA(At, 0, 1); PG8_STAGE(PG8_SB(0, 0), b2, voffB); PG8_STAGE(PG8_SB(0, 1), b2 + hstep, voffB); PG8_STAGE(PG8_SA(0, 0), a2, voffA);
            PG8_WAIT_V(8); PG8_WAIT_L(0); PG8_BAR; PG8_MMA(1, 0, At, B0); PG8_MMA(1, 1, At, B1); PG8_BAR; PG8_SCHED;
            PG8_LDB(B0, 1, 0); PG8_LDB(B1, 1, 1); PG8_SCHED; PG8_LDA(At, 1, 0); PG8_STAGE(PG8_SA(0, 1), a2 + hstep, voffA);
            PG8_WAIT_V(8); PG8_WAIT_L(0); PG8_BAR; PG8_MMA(0, 0, At, B0); PG8_MMA(0, 1, At, B1); PG8_BAR; PG8_SCHED;
            PG8_LDA(At, 1, 1); PG8_STAGE(PG8_SB(1, 0), b3, voffB); PG8_STAGE(PG8_SB(1, 1), b3 + hstep, voffB); PG8_STAGE(PG8_SA(1, 0), a3, voffA);
            PG8_WAIT_V(8); PG8_WAIT_L(0); PG8_BAR; PG8_MMA(1, 0, At, B0); PG8_MMA(1, 1, At, B1); PG8_BAR; PG8_SCHED;
            } else {
            PG8_LDB(B0, 0, 0); PG8_SCHED; PG8_LDA(At, 0, 0); PG8_STAGE(PG8_SA(1, 1), a1 + hstep, voffA);
            PG8_WAIT_L(8); PG8_BAR; PG8_WAIT_L(0); PG8_MMA(0, 0, At, B0); PG8_BAR; PG8_SCHED;
            PG8_LDB(B1, 0, 1); PG8_STAGE(PG8_SB(0, 0), b2, voffB);
            PG8_BAR; PG8_WAIT_L(0); PG8_MMA(0, 1, At, B1); PG8_BAR;
            PG8_LDA(At, 0, 1); PG8_STAGE(PG8_SA(0, 0), a2, voffA);
            PG8_BAR; PG8_WAIT_L(0); PG8_MMA(1, 0, At, B0); PG8_BAR; PG8_SCHED;
            PG8_STAGE(PG8_SB(0, 1), b2 + hstep, voffB);
            PG8_WAIT_V(6); PG8_BAR; PG8_MMA(1, 1, At, B1); PG8_BAR;
            PG8_LDB(B0, 1, 0); PG8_SCHED; PG8_LDA(At, 1, 0); PG8_STAGE(PG8_SA(0, 1), a2 + hstep, voffA);
            PG8_WAIT_L(8); PG8_BAR; PG8_WAIT_L(0); PG8_MMA(0, 0, At, B0); PG8_BAR; PG8_SCHED;
            PG8_LDB(B1, 1, 1); PG8_STAGE(PG8_SB(1, 0), b3, voffB);
            PG8_BAR; PG8_WAIT_L(0); PG8_MMA(0, 1, At, B1); PG8_BAR;
            PG8_LDA(At, 1, 1); PG8_STAGE(PG8_SA(1, 0), a3, voffA);
            PG8_BAR; PG8_WAIT_L(0); PG8_MMA(1, 0, At, B0); PG8_BAR; PG8_SCHED;
            PG8_STAGE(PG8_SB(1, 1), b3 + hstep, voffB);
            PG8_WAIT_V(6); PG8_BAR; PG8_MMA(1, 1, At, B1); PG8_BAR;
            }
        }
        if constexpr (ALIGN_EPI) { if (wr == 0) PG8_BAR; }
        if constexpr (!Epi::AFTER_DRAIN) { E(acc, cur, wr, wc, fr, fq); S.done(cur); }
        if (!has_next) break;
#pragma unroll
        for (int a = 0; a < 2; ++a)
#pragma unroll
            for (int b = 0; b < 2; ++b)
#pragma unroll
                for (int m = 0; m < 4; ++m)
#pragma unroll
                    for (int n = 0; n < 2; ++n) acc[a][b][m][n] = (f32x4){0.f, 0.f, 0.f, 0.f};
        cur = nxt; cA = nA; cB = nB; ++ui;
        if constexpr (ALIGN_EPI) { if (wr == 1) PG8_BAR; }
    }
    PG8_WAIT_V(0);
    if constexpr (!ALIGN_EPI) { if (wr == 0) PG8_BAR; }
    PG8_BAR;
    if constexpr (Epi::AFTER_DRAIN) { E.fused(acc, cur, wr, wc, fr, fq, lds, wid, lane); S.done(cur); }
#undef PG8_SA
#undef PG8_SB
#undef PG8_STAGE
#undef PG8_LDA
#undef PG8_LDB
#undef PG8_MMA
#undef PG8_WAIT_V
#undef PG8_WAIT_L
#undef PG8_BAR
#undef PG8_SCHED
}
}

#define LAS __attribute__((address_space(3)))
typedef unsigned short bf16;
typedef float f32x4 __attribute__((ext_vector_type(4)));
typedef unsigned u32x4 __attribute__((ext_vector_type(4)));
typedef unsigned u32x2 __attribute__((ext_vector_type(2)));
typedef short bf16x8 __attribute__((ext_vector_type(8)));
typedef short s16x4 __attribute__((ext_vector_type(4)));
typedef float f32x16 __attribute__((ext_vector_type(16)));
#define LDS_WAIT() asm volatile("s_waitcnt lgkmcnt(0)" ::: "memory")
__device__ __forceinline__ float wave_sum(float v) {
#pragma unroll
    for (int o = 1; o < 64; o <<= 1) v += __shfl_xor(v, o);
    return v;
}
__device__ __forceinline__ float wave_max(float v) {
#pragma unroll
    for (int o = 1; o < 64; o <<= 1) v = fmaxf(v, __shfl_xor(v, o));
    return v;
}
__device__ __forceinline__ float bf2f(unsigned b) { return __uint_as_float(b << 16); }
__device__ __forceinline__ unsigned f2bf(float f) { unsigned u = __float_as_uint(f); return (u + 0x7fffu + ((u >> 16) & 1u)) >> 16; }
__device__ __forceinline__ unsigned pk2(float lo, float hi) { return pg8::cvt_pk_bf16(lo, hi); }
__device__ __forceinline__ void unpack8(const u32x4 w, float (&v)[8]) {
    v[0] = bf2f(w.x & 0xffffu); v[1] = __uint_as_float(w.x & 0xffff0000u); v[2] = bf2f(w.y & 0xffffu); v[3] = __uint_as_float(w.y & 0xffff0000u);
    v[4] = bf2f(w.z & 0xffffu); v[5] = __uint_as_float(w.z & 0xffff0000u); v[6] = bf2f(w.w & 0xffffu); v[7] = __uint_as_float(w.w & 0xffff0000u);
}
__device__ __forceinline__ u32x4 pack8f(const float (&v)[8]) { u32x4 w; w.x = pk2(v[0], v[1]); w.y = pk2(v[2], v[3]); w.z = pk2(v[4], v[5]); w.w = pk2(v[6], v[7]); return w; }

struct Args { const float* in[23]; float* out; unsigned char* ws; };
enum { I_XP = 0, I_XS, I_CK, I_CV, I_CLF, I_CCONV, I_CP, I_CS, I_WADA, I_BADA, I_G1, I_G2, I_WIN, I_BF, I_WCONV, I_GATT, I_GCONV, I_WOUT, I_WUP, I_WDN, I_WADAF, I_BADAF, I_GF };

constexpr int NWAVES = 8, NTHR = 512;
constexpr int RING_BYTES = 131072, LDS_BYTES = 147456;

__device__ __forceinline__ void gemv24_group(const LAS float* A, LAS float* red, const float* W, int pitch, int col0, const float* bias, float* out, int opitch, int tid) {
    const int c = tid & 31, kg = tid >> 5;
    float acc[24];
#pragma unroll
    for (int r = 0; r < 24; ++r) acc[r] = 0.f;
    const float* wp = W + (size_t)(kg * 64) * pitch + col0 + c;
    const LAS float* ap = A + kg * 64;
#pragma unroll 2
    for (int k4 = 0; k4 < 16; ++k4) {
        const float w0 = wp[0], w1 = wp[pitch], w2 = wp[2 * (size_t)pitch], w3 = wp[3 * (size_t)pitch]; wp += 4 * (size_t)pitch;
#pragma unroll
        for (int r = 0; r < 24; ++r) { const f32x4 a = *(const LAS f32x4*)(ap + r * 1024 + k4 * 4); acc[r] += (a[0] * w0 + a[1] * w1) + (a[2] * w2 + a[3] * w3); }
    }
#pragma unroll
    for (int r = 0; r < 24; ++r) acc[r] += __shfl_xor(acc[r], 32);
    const int wid = tid >> 6, lane = tid & 63;
    if (lane < 32) {
#pragma unroll
        for (int r = 0; r < 24; ++r) red[(wid * 24 + r) * 32 + c] = acc[r];
    }
    __syncthreads();
    for (int o = tid; o < 768; o += NTHR) {
        const int r = o >> 5, cc = o & 31; float s = 0.f;
#pragma unroll
        for (int w = 0; w < 8; ++w) s += red[(w * 24 + r) * 32 + cc];
        if (bias) s += bias[col0 + cc];
        out[(size_t)r * opitch + col0 + cc] = s;
    }
    __syncthreads();
}

__device__ __forceinline__ void transpose_item(const float* W, int pitch, int K, bf16* WT, int k0, int nsrc0, int ndst0, LAS float* scr, int lane) {
#pragma unroll 8
    for (int i = 0; i < 32; ++i) { const int kk = 2 * i + (lane >> 5); scr[kk * 33 + (lane & 31)] = W[(size_t)(k0 + kk) * pitch + nsrc0 + (lane & 31)]; }
    LDS_WAIT(); asm volatile("" ::: "memory");
    const int c = lane & 7;
#pragma unroll
    for (int j = 0; j < 4; ++j) { const int n = (lane >> 3) + 8 * j; const LAS float* s = scr + (8 * c) * 33 + n;
        u32x4 o; o.x = pk2(s[0 * 33], s[1 * 33]); o.y = pk2(s[2 * 33], s[3 * 33]); o.z = pk2(s[4 * 33], s[5 * 33]); o.w = pk2(s[6 * 33], s[7 * 33]);
        *(u32x4*)(WT + (size_t)(ndst0 + n) * K + k0 + 8 * c) = o; }
    LDS_WAIT(); asm volatile("" ::: "memory");
}

namespace att {
constexpr int SEQ = 4096, D = 64, DM = 512, QB = 256, QBLK = 32, KVBLK = 64, NW = 8;
constexpr int SLOTB = 8192;
constexpr int LDS_K = 0, LDS_V = 2 * SLOTB, LDS_WS = 4 * SLOTB, LDS_OST = LDS_WS + 2048, LDS_F = LDS_OST + NW * 4096, LDS_END = LDS_F + 16384;
static_assert(LDS_END <= RING_BYTES, "attention LDS");
__device__ __forceinline__ int crow(int r, int hi) { return (r & 3) + 8 * (r >> 2) + 4 * hi; }
__device__ __forceinline__ void cmask(f32x16& p0, f32x16& p1, int jb, int qrel, int hi) {
    const float NEG = -INFINITY; const int kb = 64 * jb + 4 * hi;
#pragma unroll
    for (int r = 0; r < 16; ++r) { const int kv = kb + (r & 3) + 8 * (r >> 2); if (kv > qrel) p0[r] = NEG; if (kv + 32 > qrel) p1[r] = NEG; }
}
__device__ __forceinline__ void glds16(const void* gsrc, unsigned lds_dst) { unsigned keep;
    asm volatile("s_mov_b32 %0, m0\n\ts_mov_b32 m0, %2\n\ts_nop 0\n\tglobal_load_lds_dwordx4 %1, off\n\ts_mov_b32 m0, %0" : "=&s"(keep) : "v"(gsrc), "s"(lds_dst) : "memory"); }
__device__ __forceinline__ float max3f(float a, float b, float c) { return fmaxf(fmaxf(a, b), c); }
__device__ __forceinline__ float rowmax(const f32x16& p0, const f32x16& p1) {
    float a = max3f(p0[0], p0[1], p1[0]), b = max3f(p0[2], p0[3], p1[1]); a = max3f(a, p1[2], p1[3]);
#pragma unroll
    for (int r = 4; r < 16; r += 4) { a = max3f(a, p0[r], p0[r + 1]); b = max3f(b, p0[r + 2], p0[r + 3]); a = max3f(a, p1[r], p1[r + 1]); b = max3f(b, p1[r + 2], p1[r + 3]); }
    const float m = fmaxf(a, b);
    auto rr = __builtin_amdgcn_permlane32_swap(__float_as_uint(m), __float_as_uint(m), false, false);
    return fmaxf(__uint_as_float(rr[0]), __uint_as_float(rr[1]));
}
#define ATT_WAIT_BAR0() asm volatile("s_waitcnt vmcnt(0) lgkmcnt(0)\n\ts_barrier" ::: "memory")
__device__ __forceinline__ void qkt(f32x16& p0, f32x16& p1, const LAS char* Kslot, const bf16x8* qr, const f32x16& cin, int r32, int hi) {
    const LAS char* kb = Kslot + hi * 1024 + r32 * 16;
#pragma unroll
    for (int d0 = 0; d0 < 4; ++d0) {
        const bf16x8 b0 = *(const LAS bf16x8*)(kb + d0 * 2048);
        const bf16x8 b1 = *(const LAS bf16x8*)(kb + d0 * 2048 + 512);
        if (d0 == 0) { p0 = __builtin_amdgcn_mfma_f32_32x32x16_bf16(b0, qr[0], cin, 0, 0, 0); p1 = __builtin_amdgcn_mfma_f32_32x32x16_bf16(b1, qr[0], cin, 0, 0, 0); }
        else { p0 = __builtin_amdgcn_mfma_f32_32x32x16_bf16(b0, qr[d0], p0, 0, 0, 0); p1 = __builtin_amdgcn_mfma_f32_32x32x16_bf16(b1, qr[d0], p1, 0, 0, 0); }
    }
}
__device__ __forceinline__ void pv(f32x16* o, int vb, bf16x8 pa0, bf16x8 pa1, bf16x8 pa2, bf16x8 pa3) {
#pragma unroll
    for (int d0 = 0; d0 < 2; ++d0) { s16x4 lo[4], hi[4];
#pragma unroll
        for (int ks = 0; ks < 4; ++ks) {
            asm volatile("ds_read_b64_tr_b16 %0,%1 offset:%c2" : "=&v"(lo[ks]) : "v"(vb), "i"(d0 * 4096 + ks * 1024) : "memory");
            asm volatile("ds_read_b64_tr_b16 %0,%1 offset:%c2" : "=&v"(hi[ks]) : "v"(vb), "i"(d0 * 4096 + ks * 1024 + 512) : "memory"); }
        asm volatile("s_waitcnt lgkmcnt(0)" ::: "memory"); __builtin_amdgcn_sched_barrier(0);
#define ATT_PK(k) (bf16x8){lo[k][0], lo[k][1], lo[k][2], lo[k][3], hi[k][0], hi[k][1], hi[k][2], hi[k][3]}
        o[d0] = __builtin_amdgcn_mfma_f32_32x32x16_bf16(pa0, ATT_PK(0), o[d0], 0, 0, 0);
        o[d0] = __builtin_amdgcn_mfma_f32_32x32x16_bf16(pa1, ATT_PK(1), o[d0], 0, 0, 0);
        o[d0] = __builtin_amdgcn_mfma_f32_32x32x16_bf16(pa2, ATT_PK(2), o[d0], 0, 0, 0);
        o[d0] = __builtin_amdgcn_mfma_f32_32x32x16_bf16(pa3, ATT_PK(3), o[d0], 0, 0, 0);
#undef ATT_PK
    }
}
__device__ __forceinline__ void attn_unit(int b, int h, int qb, const bf16* Q, const bf16* __restrict__ K, const bf16* __restrict__ V, bf16* O, const float* __restrict__ F2g, LAS char* shm) {
    const int tid = threadIdx.x, lane = tid & 63, r32 = lane & 31, hi = lane >> 5; const int wid = __builtin_amdgcn_readfirstlane(tid >> 6);
    const long rowbase = (long)b * SEQ; const int q0 = qb * QB;
    const bf16* Qw = Q + (rowbase + q0 + wid * QBLK) * DM + h * D;
    const bf16* Kh = K + rowbase * DM + h * D, *Vh = V + rowbase * DM + h * D;
    const unsigned lds0 = (unsigned)(uintptr_t)shm;
    LAS float* wsf = (LAS float*)(shm + LDS_WS) + wid * 64;
    LAS float* Fl = (LAS float*)(shm + LDS_F);
    const bf16* ksrc = Kh + (long)lane * DM + wid * 8;
    const bf16* vsrc = Vh + (long)(16 * (wid & 3) + (lane >> 2)) * DM + (wid >> 2) * 32 + (lane & 3) * 8;
    const unsigned kdst = lds0 + LDS_K + wid * 1024, vdst = lds0 + LDS_V + wid * 1024;
#define DMA_K(t, slot) glds16(ksrc + (long)(t) * KVBLK * DM, (unsigned)__builtin_amdgcn_readfirstlane(kdst + (slot)))
#define DMA_V(t, slot) glds16(vsrc + (long)(t) * KVBLK * DM, (unsigned)__builtin_amdgcn_readfirstlane(vdst + (slot)))
    const int vb0 = (int)(lds0 + LDS_V) + ((lane >> 4) & 1) * 32 + (lane & 3) * 8 + (4 * hi + ((lane & 15) >> 2)) * 64;
    const int NT = (q0 + QB) / KVBLK;
    DMA_K(0, 0); DMA_V(0, 0);
    for (int i = tid; i < NT * 64; i += NTHR) Fl[i] = F2g[i];
    bf16x8 qr[4];
#pragma unroll
    for (int d0 = 0; d0 < 4; ++d0) qr[d0] = *reinterpret_cast<const bf16x8*>(&Qw[(long)r32 * DM + d0 * 16 + hi * 8]);
    const float fqv = F2g[q0 + wid * QBLK + r32];
    f32x16 cin;
#pragma unroll
    for (int r = 0; r < 16; ++r) cin[r] = fqv;
    float mrun = -1e30f, l_reg = 0.f; f32x16 o[2];
#pragma unroll
    for (int r = 0; r < 16; ++r) { o[0][r] = 0.f; o[1][r] = 0.f; }
    const int qrel = wid * QBLK + r32;
    for (int t = 0; t < NT; ++t) {
        const int slot = (t & 1) * SLOTB;
        ATT_WAIT_BAR0();
        if (t + 1 < NT) { DMA_K(t + 1, slot ^ SLOTB); DMA_V(t + 1, slot ^ SLOTB); }
        const int jb = t - (NT - 4);
        if (jb >= 0 && 64 * jb > wid * QBLK + 31) continue;
        f32x16 p0, p1;
        qkt(p0, p1, (const LAS char*)(shm + LDS_K + slot), qr, cin, r32, hi);
#pragma unroll
        for (int g = 0; g < 4; ++g) {
            const f32x4 f0 = *(const LAS f32x4*)(Fl + 64 * t + 8 * g + 4 * hi), f1 = *(const LAS f32x4*)(Fl + 64 * t + 32 + 8 * g + 4 * hi);
#pragma unroll
            for (int j = 0; j < 4; ++j) { p0[4 * g + j] -= f0[j]; p1[4 * g + j] -= f1[j]; }
        }
        if (jb >= 0) cmask(p0, p1, jb, qrel, hi);
        const float rm = rowmax(p0, p1);
        const float mn = fmaxf(mrun, rm), alpha = __builtin_amdgcn_exp2f(mrun - mn); mrun = mn;
        float sacc = 0.f;
#pragma unroll
        for (int r = 0; r < 16; ++r) { p0[r] = __builtin_amdgcn_exp2f(p0[r] - mn); p1[r] = __builtin_amdgcn_exp2f(p1[r] - mn); sacc += p0[r] + p1[r]; }
        l_reg = l_reg * alpha + sacc;
        if (hi == 0) wsf[r32] = alpha;
        u32x4 pw0, pw1, pw2, pw3;
        pw0 = (u32x4){pk2(p0[0], p0[1]), pk2(p0[2], p0[3]), pk2(p0[4], p0[5]), pk2(p0[6], p0[7])};
        pw1 = (u32x4){pk2(p0[8], p0[9]), pk2(p0[10], p0[11]), pk2(p0[12], p0[13]), pk2(p0[14], p0[15])};
        pw2 = (u32x4){pk2(p1[0], p1[1]), pk2(p1[2], p1[3]), pk2(p1[4], p1[5]), pk2(p1[6], p1[7])};
        pw3 = (u32x4){pk2(p1[8], p1[9]), pk2(p1[10], p1[11]), pk2(p1[12], p1[13]), pk2(p1[14], p1[15])};
        LDS_WAIT();
#pragma unroll
        for (int r = 0; r < 16; ++r) { const float f = wsf[crow(r, hi)]; o[0][r] *= f; o[1][r] *= f; }
        pv(o, vb0 + slot, __builtin_bit_cast(bf16x8, pw0), __builtin_bit_cast(bf16x8, pw1), __builtin_bit_cast(bf16x8, pw2), __builtin_bit_cast(bf16x8, pw3));
    }
    { auto rr = __builtin_amdgcn_permlane32_swap(__float_as_uint(l_reg), __float_as_uint(l_reg), false, false); l_reg = __uint_as_float(rr[0]) + __uint_as_float(rr[1]); }
    if (hi == 0) wsf[32 + r32] = l_reg; LDS_WAIT();
    float rli[16];
#pragma unroll
    for (int r = 0; r < 16; ++r) rli[r] = __builtin_amdgcn_rcpf(wsf[32 + crow(r, hi)]);
    bf16* Ow = O + (rowbase + q0 + wid * QBLK) * DM + h * D;
    { LAS bf16* stg = (LAS bf16*)(shm + LDS_OST) + wid * 2048;
#pragma unroll
      for (int r = 0; r < 16; ++r) { const int orow = crow(r, hi);
#pragma unroll
        for (int d0 = 0; d0 < 2; ++d0) stg[orow * 64 + d0 * 32 + r32] = (bf16)f2bf(o[d0][r] * rli[r]); }
      LDS_WAIT();
#pragma unroll
      for (int i = 0; i < 4; ++i) { const int row = i * 8 + (lane >> 3), ch = lane & 7; const u32x4 v = *(const LAS u32x4*)(stg + row * 64 + ch * 8); *(u32x4*)(Ow + (long)row * DM + ch * 8) = v; } }
    asm volatile("s_waitcnt vmcnt(0) lgkmcnt(0)\n\ts_barrier" ::: "memory");
#undef DMA_K
#undef DMA_V
}
}

__device__ __forceinline__ void attn_sample_unit(int b, int h, int sp, const Args& a, LAS char* shm) {
    const int tid = threadIdx.x, lane = tid & 63; const int wid = __builtin_amdgcn_readfirstlane(tid >> 6);
    LAS float* qs = (LAS float*)shm;
    LAS float* ps = (LAS float*)(shm + 4096) + wid * 1024;
    LAS float* red = (LAS float*)(shm + 4096 + 32768);
    const bf16* Qb = (const bf16*)(a.ws + R1_Q) + (size_t)(MP + 16 * b) * 512 + h * 64;
    for (int i = tid; i < 1024; i += NTHR) qs[i] = bf2f(Qb[(i >> 6) * 512 + (i & 63)]);
    const float* F = (const float*)(a.ws + WS_FSS) + (size_t)(b * 8 + h) * 4112;
    __syncthreads();
    float m[16], ll[16], o[16];
#pragma unroll
    for (int i = 0; i < 16; ++i) { m[i] = -1e30f; ll[i] = 0.f; o[i] = 0.f; }
    const int nch = (sp == 3 && wid == 0) ? 3 : 2;
    for (int ch = 0; ch < nch; ++ch) {
        int key0, nvalid; const float* kbase; const float* vbase;
        if (ch < 2) { key0 = 1024 * sp + 128 * wid + 64 * ch; nvalid = 64; const size_t off = ((size_t)(b * 4096 + key0) * 8 + h) * 64; kbase = a.in[I_CK] + off; vbase = a.in[I_CV] + off; }
        else { key0 = 4096; nvalid = 16; const size_t off = ((size_t)(b * 16) * 8 + h) * 64; kbase = a.out + O_KS + off; vbase = a.out + O_VS + off; }
        const bool valid = lane < nvalid; const int key = key0 + lane;
        const float* kp = kbase + (size_t)(valid ? lane : 0) * 512;
        float s[16];
#pragma unroll
        for (int i = 0; i < 16; ++i) s[i] = 0.f;
#pragma unroll 4
        for (int d4 = 0; d4 < 16; ++d4) {
            const f32x4 kk = *(const f32x4*)(kp + 4 * d4);
#pragma unroll
            for (int i = 0; i < 16; ++i) { const f32x4 q4 = *(const LAS f32x4*)(qs + i * 64 + 4 * d4); s[i] += (q4[0] * kk[0] + q4[1] * kk[1]) + (q4[2] * kk[2] + q4[3] * kk[3]); }
        }
        const float fk = F[valid ? key : 0];
#pragma unroll
        for (int i = 0; i < 16; ++i) {
            float sv = s[i] + (F[4096 + i] - fk);
            if (!valid || key > 4096 + i) sv = -INFINITY;
            const float cm = wave_max(sv), mn = fmaxf(m[i], cm), al = __builtin_amdgcn_exp2f(m[i] - mn), p = __builtin_amdgcn_exp2f(sv - mn);
            ll[i] = ll[i] * al + p; o[i] *= al; m[i] = mn; s[i] = p;
        }
#pragma unroll
        for (int i4 = 0; i4 < 4; ++i4) *(LAS f32x4*)(ps + lane * 16 + 4 * i4) = (f32x4){s[4 * i4], s[4 * i4 + 1], s[4 * i4 + 2], s[4 * i4 + 3]};
        LDS_WAIT();
#pragma unroll 4
        for (int k = 0; k < nvalid; ++k) {
            const float v = vbase[(size_t)k * 512 + lane];
#pragma unroll
            for (int i4 = 0; i4 < 4; ++i4) { const f32x4 p4 = *(const LAS f32x4*)(ps + k * 16 + 4 * i4);
                o[4 * i4] += p4[0] * v; o[4 * i4 + 1] += p4[1] * v; o[4 * i4 + 2] += p4[2] * v; o[4 * i4 + 3] += p4[3] * v; }
        }
        LDS_WAIT();
    }
#pragma unroll
    for (int i = 0; i < 16; ++i) ll[i] = wave_sum(ll[i]);
#pragma unroll
    for (int i = 0; i < 16; ++i) red[(wid * 16 + i) * 66 + lane] = o[i];
    if (lane == 0) {
#pragma unroll
        for (int i = 0; i < 16; ++i) { red[(wid * 16 + i) * 66 + 64] = m[i]; red[(wid * 16 + i) * 66 + 65] = ll[i]; }
    }
    __syncthreads();
    {
        const int i = tid >> 5, dd = tid & 31;
        float M = -1e30f;
#pragma unroll
        for (int w = 0; w < 8; ++w) M = fmaxf(M, red[(w * 16 + i) * 66 + 64]);
        float L = 0.f, O0 = 0.f, O1 = 0.f;
#pragma unroll
        for (int w = 0; w < 8; ++w) { const float f = __builtin_amdgcn_exp2f(red[(w * 16 + i) * 66 + 64] - M); L += red[(w * 16 + i) * 66 + 65] * f; O0 += red[(w * 16 + i) * 66 + dd] * f; O1 += red[(w * 16 + i) * 66 + dd + 32] * f; }
        float* pp = (float*)(a.ws + WS_PART) + ((size_t)((b * 8 + h) * 4 + sp) * 16 + i) * 66;
        pp[dd] = O0; pp[dd + 32] = O1; if (dd == 0) { pp[64] = M; pp[65] = L; }
    }
    __syncthreads();
}

__device__ __forceinline__ void scan_seq(int seq, const Args& a, LAS float* sm) {
    const int tid = threadIdx.x, lane = tid & 63, wid = tid >> 6;
    const bool smp = seq >= 128; const int s = smp ? seq - 128 : seq; const int b = s >> 3, h = s & 7;
    const float* src = smp ? a.in[I_CLF] + (size_t)(b * 4096) * 8 + h : a.out + O_LP + (size_t)(b * 4096) * 8 + h;
    float v[8]; float run = 0.f;
#pragma unroll
    for (int i = 0; i < 8; ++i) { run += src[(size_t)(tid * 8 + i) * 8]; v[i] = run; }
    float inc = run;
#pragma unroll
    for (int o = 1; o < 64; o <<= 1) { const float t = __shfl_up(inc, o); if (lane >= o) inc += t; }
    if (lane == 63) sm[wid] = inc;
    __syncthreads();
    float off = inc - run;
    for (int w = 0; w < wid; ++w) off += sm[w];
    float* dst = smp ? (float*)(a.ws + WS_FSS) + (size_t)s * 4112 : (float*)(a.ws + WS_FS) + (size_t)s * 4096;
#pragma unroll
    for (int i = 0; i < 8; ++i) dst[tid * 8 + i] = (off + v[i]) * LOG2E;
    if (smp && tid == NTHR - 1) {
        float r2 = off + v[7];
        for (int i = 0; i < 16; ++i) { r2 += a.out[O_LS + (size_t)(b * 16 + i) * 8 + h]; dst[4096 + i] = r2 * LOG2E; }
    }
    __syncthreads();
}

__global__ void __launch_bounds__(NTHR, 2) hymba_fwd(Args a) {
    extern __shared__ __attribute__((aligned(16))) unsigned char lds_raw[];
    LAS unsigned char* lds = (LAS unsigned char*)lds_raw;
    cg::grid_group grid = cg::this_grid();
    const int tid = threadIdx.x, lane = tid & 63; const int wave = __builtin_amdgcn_readfirstlane(tid >> 6);
    const int G = gridDim.x, bx = blockIdx.x;
    const int vcu = (G % 8 == 0) ? (bx % 8) * (G / 8) + bx / 8 : bx;
    const int gw = vcu * NWAVES + wave, NGW = G * NWAVES;
    unsigned char* ws = a.ws;
    float* mod = (float*)(ws + WS_MOD); float* modf = (float*)(ws + WS_MODF); float* gm2 = (float*)(ws + WS_GM2); float* BU = (float*)(ws + WS_BU);
    bf16* Win_t = (bf16*)(ws + WS_WIN); bf16* Wout_t = (bf16*)(ws + WS_WOUT); bf16* Wup_t = (bf16*)(ws + WS_WUP); bf16* Wdn_t = (bf16*)(ws + WS_WDN);
    bf16* XN = (bf16*)(ws + R1_XN); bf16* QB = (bf16*)(ws + R1_Q); bf16* Hb = (bf16*)(ws + WS_R1);
    float* X1 = (float*)(ws + WS_X1); bf16* A2 = (bf16*)(ws + WS_A2); float* SS = (float*)(ws + WS_SS);

    {
        LAS float* A = (LAS float*)lds; LAS float* red = (LAS float*)(lds + 98304);
        for (int i = tid; i < 24 * 1024; i += NTHR) { const int r = i >> 10, k = i & 1023; const float c = (r < 16) ? a.in[I_CP][r * 1024 + k] : a.in[I_CS][(r - 16) * 1024 + k]; A[i] = c / (1.f + __expf(-c)); }
        __syncthreads();
        for (int grp = bx; grp < 256; grp += G) {
            const int col = grp * 32;
            if (col < 6144) gemv24_group(A, red, a.in[I_WADA], 6144, col, a.in[I_BADA], mod, 6144, tid);
            else gemv24_group(A, red, a.in[I_WADAF], 2048, col - 6144, a.in[I_BADAF], modf, 2048, tid);
        }
        __syncthreads();
    }
    {
        LAS float* scr = (LAS float*)(lds + wave * 16384);
        constexpr int I_IN = 16 * 96, I_OUT = 16 * 32, I_UP = 16 * 128, I_DN = 64 * 32, NITEMS = I_IN + I_OUT + I_UP + I_DN;
        for (int it = gw; it < NITEMS; it += NGW) {
            int r = it;
            if (r < I_IN) { const int kb = r / 96, nb = r % 96; transpose_item(a.in[I_WIN], PROJ, 1024, Win_t, 64 * kb, 32 * nb + (nb >= 48 ? 8 : 0), 32 * nb, scr, lane); continue; } r -= I_IN;
            if (r < I_OUT) { const int kb = r / 32, nb = r % 32; transpose_item(a.in[I_WOUT], 1024, 1024, Wout_t, 64 * kb, 32 * nb, 32 * nb, scr, lane); continue; } r -= I_OUT;
            if (r < I_UP) { const int kb = r / 128, nb = r % 128; transpose_item(a.in[I_WUP], 4096, 1024, Wup_t, 64 * kb, 32 * nb, 32 * nb, scr, lane); continue; } r -= I_UP;
            { const int kb = r / 32, nb = r % 32; transpose_item(a.in[I_WDN], 1024, 4096, Wdn_t, 64 * kb, 32 * nb, 32 * nb, scr, lane); }
        }
    }
    grid.sync();
    {
        LAS float* WfT = (LAS float*)lds;
        for (int i = tid; i < 8192; i += NTHR) { const int hh = i & 7, k = i >> 3; WfT[hh * 1024 + k] = a.in[I_WIN][(size_t)k * PROJ + 1536 + hh]; }
        for (int i = bx * NTHR + tid; i < 24 * 1024; i += G * NTHR) { const int r = i >> 10, k = i & 1023; gm2[i] = a.in[I_G2][k] * (1.f + mod[(size_t)r * 6144 + 4096 + k]); }
        __syncthreads();
        f32x4 g1v[4];
#pragma unroll
        for (int j = 0; j < 4; ++j) g1v[j] = ((const f32x4*)a.in[I_G1])[lane + 64 * j];
        for (int row = gw; row < MPAD; row += NGW) {
            u32x2* xo = (u32x2*)(XN + (size_t)row * 1024) + lane;
            if (row >= MP + MS) {
#pragma unroll
                for (int j = 0; j < 4; ++j) xo[64 * j] = (u32x2){0u, 0u};
                continue;
            }
            const float* xr = (row < MP) ? a.in[I_XP] + (size_t)row * 1024 : a.in[I_XS] + (size_t)(row - MP) * 1024;
            const int mr = (row < MP) ? (row >> 12) : 16 + ((row - MP) >> 4);
            const f32x4* x4 = (const f32x4*)xr + lane; const f32x4* sh4 = (const f32x4*)(mod + (size_t)mr * 6144) + lane; const f32x4* sc4 = (const f32x4*)(mod + (size_t)mr * 6144 + 1024) + lane;
            f32x4 v[4]; float ss = 0.f;
#pragma unroll
            for (int j = 0; j < 4; ++j) { v[j] = x4[64 * j]; ss += (v[j][0] * v[j][0] + v[j][1] * v[j][1]) + (v[j][2] * v[j][2] + v[j][3] * v[j][3]); }
            const float rstd = 1.0f / sqrtf(wave_sum(ss) * (1.0f / 1024.0f) + NORM_EPS);
            float fl[8];
#pragma unroll
            for (int hh = 0; hh < 8; ++hh) fl[hh] = 0.f;
#pragma unroll
            for (int j = 0; j < 4; ++j) {
                const f32x4 hv = (v[j] * rstd) * g1v[j] * (sc4[64 * j] + 1.0f) + sh4[64 * j];
                xo[64 * j] = (u32x2){pk2(hv[0], hv[1]), pk2(hv[2], hv[3])};
#pragma unroll
                for (int hh = 0; hh < 8; ++hh) { const f32x4 w = *(const LAS f32x4*)(WfT + hh * 1024 + 4 * lane + 256 * j); fl[hh] += (hv[0] * w[0] + hv[1] * w[1]) + (hv[2] * w[2] + hv[3] * w[3]); }
            }
            float z = 0.f;
#pragma unroll
            for (int hh = 0; hh < 8; ++hh) { const float t = wave_sum(fl[hh]); z = (lane == hh) ? t : z; }
            if (lane < 8) {
                z += a.in[I_BF][lane];
                const float lf = fminf(z, 0.f) - log1pf(__expf(-fabsf(z)));
                if (row < MP) a.out[O_LP + (size_t)row * 8 + lane] = lf; else a.out[O_LS + (size_t)(row - MP) * 8 + lane] = lf;
            }
        }
    }
    grid.sync();
    {
        for (int seq = bx; seq < 192; seq += G) scan_seq(seq, a, (LAS float*)lds);
        __syncthreads();
        pg8::Gemm g{XN, Win_t, MPAD, NIN, 1024}; pg8::StaticOrder S; S.init(MPAD, NIN, G, bx);
        pg8::EpiIn E{QB, a.out};
        pg8::gemm_phase<pg8::EpiIn, pg8::StaticOrder, true, true>(lds, g, S, E);
    }
    grid.sync();
    {
        const bf16* Qp = QB; const bf16* Kp = QB + BUF512; const bf16* Vp = QB + 2 * BUF512;
        for (int u = vcu; u < 256; u += G) attn_sample_unit(u >> 5, (u >> 2) & 7, u & 3, a, (LAS char*)lds);
        for (int u = vcu; u < 2048; u += G) {
            const int c = u & 255, i = u >> 8; const int bh = c >> 1, par = c & 1;
            const int k = 7 - i;
            const int qb = par ? ((k & 1) ? 4 * (k >> 1) + 2 : 4 * (k >> 1) + 1) : ((k & 1) ? 4 * (k >> 1) + 3 : 4 * (k >> 1));
            att::attn_unit(bh >> 3, bh & 7, qb, Qp, Kp, Vp, (bf16*)Qp, (const float*)(ws + WS_FS) + (size_t)bh * 4096, (LAS char*)lds);
        }
    }
    grid.sync();
    {
        {
            LAS float* A = (LAS float*)lds; LAS float* red = (LAS float*)(lds + 98304);
            if (bx < 128) {
                for (int i = tid; i < 24 * 1024; i += NTHR) { const int r = i >> 10, k = i & 1023; A[i] = mod[(size_t)r * 6144 + 3072 + k]; }
                __syncthreads();
                for (int grp = bx; grp < 128; grp += G) gemv24_group(A, red, a.in[I_WUP], 4096, grp * 32, nullptr, BU, 4096, tid);
            }
        }
        const bf16* Ob = QB; const bf16* BGb = QB + 3 * BUF512; const bf16* CGb = QB + 4 * BUF512; const bf16* Ub = QB + 5 * BUF512;
        bf16* MG = XN;
        const int c0 = 8 * lane;
        float gatt[8], gconv[8], w0[8], w1[8], w2[8];
#pragma unroll
        for (int j = 0; j < 8; ++j) { gatt[j] = a.in[I_GATT][c0 + j]; gconv[j] = a.in[I_GCONV][c0 + j]; w0[j] = a.in[I_WCONV][c0 + j]; w1[j] = a.in[I_WCONV][512 + c0 + j]; w2[j] = a.in[I_WCONV][1024 + c0 + j]; }
        for (int run = gw; run < 2048 + 8; run += NGW) {
            const bool smp = run >= 2048; const int bs = run - 2048;
            const int row0 = smp ? MP + bs * 16 : run * 32; const int nrows = smp ? 16 : 32;
            float um2[8], um1[8];
            if (smp) {
#pragma unroll
                for (int j = 0; j < 8; ++j) { um2[j] = a.in[I_CCONV][(size_t)(bs * 2) * 512 + c0 + j]; um1[j] = a.in[I_CCONV][(size_t)(bs * 2 + 1) * 512 + c0 + j]; }
            } else if ((row0 & 4095) == 0) {
#pragma unroll
                for (int j = 0; j < 8; ++j) { um2[j] = 0.f; um1[j] = 0.f; }
            } else {
                float ca[8], ua[8];
                unpack8(*(const u32x4*)(CGb + (size_t)(row0 - 2) * 512 + c0), ca); unpack8(*(const u32x4*)(Ub + (size_t)(row0 - 2) * 512 + c0), ua);
#pragma unroll
                for (int j = 0; j < 8; ++j) um2[j] = ca[j] * ua[j];
                unpack8(*(const u32x4*)(CGb + (size_t)(row0 - 1) * 512 + c0), ca); unpack8(*(const u32x4*)(Ub + (size_t)(row0 - 1) * 512 + c0), ua);
#pragma unroll
                for (int j = 0; j < 8; ++j) um1[j] = ca[j] * ua[j];
            }
            for (int rr = 0; rr < nrows; ++rr) {
                const int row = row0 + rr;
                float at[8];
                if (!smp) unpack8(*(const u32x4*)(Ob + (size_t)row * 512 + c0), at);
                else {
                    const int hh = lane >> 3, d0 = (lane & 7) * 8;
                    const float* pp = (const float*)(ws + WS_PART) + ((size_t)((bs * 8 + hh) * 4) * 16 + rr) * 66;
                    float M = -1e30f;
#pragma unroll
                    for (int sp = 0; sp < 4; ++sp) M = fmaxf(M, pp[(size_t)sp * 16 * 66 + 64]);
                    float L = 0.f;
#pragma unroll
                    for (int j = 0; j < 8; ++j) at[j] = 0.f;
#pragma unroll
                    for (int sp = 0; sp < 4; ++sp) { const float* q = pp + (size_t)sp * 16 * 66; const float f = __builtin_amdgcn_exp2f(q[64] - M); L += q[65] * f;
#pragma unroll
                        for (int j = 0; j < 8; ++j) at[j] += q[d0 + j] * f; }
                    const float rl = 1.0f / L;
#pragma unroll
                    for (int j = 0; j < 8; ++j) at[j] *= rl;
                }
                float ss = 0.f;
#pragma unroll
                for (int j = 0; j < 8; ++j) ss += at[j] * at[j];
                const float ra = 1.0f / sqrtf(wave_sum(ss) * (1.0f / 512.0f) + NORM_EPS);
#pragma unroll
                for (int j = 0; j < 8; ++j) at[j] = at[j] * ra * gatt[j];
                *(u32x4*)(MG + (size_t)row * 1024 + c0) = pack8f(at);
                float bgv[8], ca[8], ua[8], u8[8], y[8];
                unpack8(*(const u32x4*)(BGb + (size_t)row * 512 + c0), bgv); unpack8(*(const u32x4*)(CGb + (size_t)row * 512 + c0), ca); unpack8(*(const u32x4*)(Ub + (size_t)row * 512 + c0), ua);
                float s2 = 0.f;
#pragma unroll
                for (int j = 0; j < 8; ++j) { u8[j] = ca[j] * ua[j]; y[j] = bgv[j] * (w0[j] * um2[j] + w1[j] * um1[j] + w2[j] * u8[j]); s2 += y[j] * y[j]; }
                const float rc = 1.0f / sqrtf(wave_sum(s2) * (1.0f / 512.0f) + NORM_EPS);
#pragma unroll
                for (int j = 0; j < 8; ++j) y[j] = y[j] * rc * gconv[j];
                *(u32x4*)(MG + (size_t)row * 1024 + 512 + c0) = pack8f(y);
                if (!smp) { const int t = row & 4095; if (t >= 4094) { float* co = a.out + O_CP + (size_t)((row >> 12) * 2 + (t - 4094)) * 512 + c0;
#pragma unroll
                        for (int j = 0; j < 8; ++j) co[j] = u8[j]; } }
                else if (rr >= 14) { float* co = a.out + O_CS + (size_t)(bs * 2 + (rr - 14)) * 512 + c0;
#pragma unroll
                        for (int j = 0; j < 8; ++j) co[j] = u8[j]; }
#pragma unroll
                for (int j = 0; j < 8; ++j) { um2[j] = um1[j]; um1[j] = u8[j]; }
            }
        }
    }
    grid.sync();
    {
        pg8::Gemm g{XN, Wout_t, MPAD, 1024, 1024}; pg8::StaticOrder S; S.init(MPAD, 1024, G, bx);
        pg8::EpiOut E{a.in[I_XP], a.in[I_XS], mod, gm2, X1, A2, SS};
        pg8::gemm_phase<pg8::EpiOut, pg8::StaticOrder, true, true>(lds, g, S, E);
    }
    grid.sync();
    {
        pg8::Gemm g{A2, Wup_t, MPAD, FFD, 1024}; pg8::StaticOrder S; S.init(MPAD, FFD, G, bx);
        pg8::EpiUp E{SS, BU, Hb};
        pg8::gemm_phase<pg8::EpiUp, pg8::StaticOrder, true, true>(lds, g, S, E);
    }
    grid.sync();
    {
        pg8::Gemm g{Hb, Wdn_t, MPAD, 1024, FFD}; pg8::StaticOrder S; S.init(MPAD, 1024, G, bx);
        pg8::EpiDown E{mod, X1};
        pg8::gemm_phase<pg8::EpiDown, pg8::StaticOrder, true, true>(lds, g, S, E);
    }
    grid.sync();
    {
        f32x4 gfv[4];
#pragma unroll
        for (int j = 0; j < 4; ++j) gfv[j] = ((const f32x4*)a.in[I_GF])[lane + 64 * j];
        for (int row = gw; row < MP + MS; row += NGW) {
            const int mr = (row < MP) ? (row >> 12) : 16 + ((row - MP) >> 4);
            const f32x4* x4 = (const f32x4*)(X1 + (size_t)row * 1024) + lane;
            const f32x4* sh4 = (const f32x4*)(modf + (size_t)mr * 2048) + lane; const f32x4* sc4 = (const f32x4*)(modf + (size_t)mr * 2048 + 1024) + lane;
            f32x4* yo = (f32x4*)((row < MP) ? a.out + O_YP + (size_t)row * 1024 : a.out + O_YS + (size_t)(row - MP) * 1024) + lane;
            f32x4 v[4]; float ss = 0.f;
#pragma unroll
            for (int j = 0; j < 4; ++j) { v[j] = x4[64 * j]; ss += (v[j][0] * v[j][0] + v[j][1] * v[j][1]) + (v[j][2] * v[j][2] + v[j][3] * v[j][3]); }
            const float rstd = 1.0f / sqrtf(wave_sum(ss) * (1.0f / 1024.0f) + NORM_EPS);
#pragma unroll
            for (int j = 0; j < 4; ++j) yo[64 * j] = (v[j] * rstd) * gfv[j] * (sc4[64 * j] + 1.0f) + sh4[64 * j];
        }
    }
}

extern "C" void kernel_launch(void* const* d_in, const int* in_sizes, int n_in, void* d_out, int out_size, void* d_ws, size_t ws_size, hipStream_t stream) {
    static int grid = 0;
    if (grid == 0) {
        if (n_in != 23 || ws_size < WS_END) { fprintf(stderr, "kernel_launch: expected 23 inputs and >= %zu bytes of workspace; got %d, %zu\n", (size_t)WS_END, n_in, ws_size); grid = -1; return; }
        int dev = 0, cus = 0, per_cu = 0;
        hipGetDevice(&dev); hipDeviceGetAttribute(&cus, hipDeviceAttributeMultiprocessorCount, dev);
        hipFuncSetAttribute((const void*)hymba_fwd, hipFuncAttributeMaxDynamicSharedMemorySize, LDS_BYTES);
        hipOccupancyMaxActiveBlocksPerMultiprocessor(&per_cu, (const void*)hymba_fwd, NTHR, LDS_BYTES);
        if (per_cu < 1) { fprintf(stderr, "kernel_launch: occupancy query says %d blocks per CU\n", per_cu); per_cu = 1; }
        if (per_cu > 1) per_cu = 1;
        grid = cus * per_cu;
        (void)hipGetLastError();
    }
    if (grid < 0) return;
    Args a{};
    for (int i = 0; i < 23; ++i) a.in[i] = (const float*)d_in[i];
    a.out = (float*)d_out; a.ws = (unsigned char*)d_ws;
    void* params[] = {&a};
    hipError_t e = hipLaunchCooperativeKernel((const void*)hymba_fwd, dim3(grid), dim3(NTHR), params, LDS_BYTES, stream);
    if (e != hipSuccess) fprintf(stderr, "cooperative launch failed: %s (grid %d)\n", hipGetErrorString(e), grid);
}
```

```cpp
#include <hip/hip_runtime.h>
#include <hip/hip_cooperative_groups.h>
#include <cstdio>
#include <cstdint>
#include <cmath>
namespace cg = cooperative_groups;

constexpr int MP = 65536;
constexpr int MS = 128;
constexpr int MPAD = 65792;
constexpr int DMODEL = 1024, FFD = 4096, NIN = 3072, PROJ = 3080;
constexpr float NORM_EPS = 1e-6f;
constexpr float LOG2E = 1.4426950408889634f;
constexpr float QSCALE = 0.125f * 1.4426950408889634f;
constexpr size_t O_YP = 0, O_YS = 67108864, O_KP = 67239936, O_VP = 100794368, O_LP = 134348800, O_CP = 134873088,
                 O_KS = 134889472, O_VS = 134955008, O_LS = 135020544, O_CS = 135021568;
constexpr size_t MiB = 1u << 20;
constexpr size_t WS_WIN = 0, WS_WOUT = 6 * MiB, WS_WUP = 8 * MiB, WS_WDN = 16 * MiB;
constexpr size_t WS_MOD = 24 * MiB, WS_MODF = 24 * MiB + 640 * 1024, WS_GM2 = 24 * MiB + 896 * 1024, WS_BU = 25 * MiB;
constexpr size_t WS_SST = 25 * MiB + 512 * 1024;
constexpr size_t WS_FS = 26 * MiB, WS_FSS = 28 * MiB, WS_PART = 30 * MiB, WS_SS = 32 * MiB;
constexpr size_t WS_R1 = 40 * MiB;
constexpr size_t R1_XN = WS_R1, R1_Q = WS_R1 + (size_t)MPAD * 2048;
constexpr size_t BUF512 = (size_t)MPAD * 512;
constexpr size_t WS_X1 = WS_R1 + 514 * MiB;
constexpr size_t WS_A2 = WS_X1 + 257 * MiB;
constexpr size_t WS_END = WS_A2 + 129 * MiB;
static_assert((size_t)MPAD * 8192 == 514 * MiB, "H size");

namespace pg8 {
#define PG8_LAS __attribute__((address_space(3)))
typedef unsigned short bf16_t;
typedef short bf16x8 __attribute__((ext_vector_type(8)));
typedef float f32x4 __attribute__((ext_vector_type(4)));
typedef unsigned u32x4 __attribute__((ext_vector_type(4)));
constexpr int BM = 256, BK = 64, HALF = 128, HTB = HALF * BK * 2  , STAGE_BYTES = 8 * HTB, NXCD = 8, WGM = 8;

__host__ __device__ __forceinline__ int lds_byte(int r, int c) { const int st = (r >> 4) * 2 + (c >> 5), rr = r & 15, cc = c & 31, ob = rr * 64 + cc * 2; return st * 1024 + (ob ^ (((ob >> 9) & 1) << 5)); }
__host__ __device__ __forceinline__ void stage_rc(int b, int& R, int& C) { const int st = b / 1024, sb = b % 1024, swz = sb ^ (((sb >> 9) & 1) << 5); R = (st >> 1) * 16 + swz / 64; C = (st & 1) * 32 + (swz % 64) / 2; }
__host__ __device__ __forceinline__ int perm32(int rho) { const int n = rho >> 4, i = rho & 15; return 8 * (i >> 2) + 4 * n + (i & 3); }

struct Unit { int pm, pn; };
struct Gemm { const bf16_t* A; const bf16_t* Bt; int M, N, K; };

struct StaticOrder {
    int nM, nN, nwg, G, c;
    __host__ __device__ void init(int M, int N, int G_, int c_) { nM = M / BM; nN = N / BM; nwg = nM * nN; G = G_; c = c_; }
    __host__ __device__ bool next(int i, Unit& u) const {
        const long L = (long)i * G + c; if (L >= nwg) return false;
        int wgid = (int)L; { const int q = nwg / NXCD, r = nwg % NXCD, xcd = wgid % NXCD, off = wgid / NXCD; wgid = (xcd < r ? xcd * (q + 1) : r * (q + 1) + (xcd - r) * q) + off; }
        const int nig = WGM * nN, gid = wgid / nig, fm = gid * WGM, gsz = (nM - fm) < WGM ? (nM - fm) : WGM;
        u.pm = fm + ((wgid % nig) % gsz); u.pn = (wgid % nig) / gsz; return true;
    }
    __device__ __forceinline__ void a_ready(const Unit&) const {}
    __device__ __forceinline__ void done(const Unit&) const {}
};

__device__ __forceinline__ unsigned cvt_pk_bf16(float lo, float hi) { unsigned r; asm volatile("v_cvt_pk_bf16_f32 %0, %1, %2" : "=v"(r) : "v"(lo), "v"(hi)); return r; }
typedef float f32x2 __attribute__((ext_vector_type(2)));
__device__ __forceinline__ u32x4 pack8(const f32x4 v0, const f32x4 v1) { u32x4 w; w.x = cvt_pk_bf16(v0[0], v0[1]); w.y = cvt_pk_bf16(v0[2], v0[3]); w.z = cvt_pk_bf16(v1[0], v1[1]); w.w = cvt_pk_bf16(v1[2], v1[3]); return w; }
__device__ __forceinline__ float sumsq4(const f32x4 v) { return (v[0] * v[0] + v[1] * v[1]) + (v[2] * v[2] + v[3] * v[3]); }

struct EpiIn {
    static constexpr bool PERM = true, AFTER_DRAIN = false;
    bf16_t* QB; float* out;
    __device__ __forceinline__ void operator()(const f32x4 (&acc)[2][2][4][2], const Unit& u, int wr, int wc, int fr, int fq) const {
        const int t = u.pn >> 1;
        bf16_t* base = QB + (size_t)t * BUF512;
        const int col0 = (u.pn & 1) * 256 + wc * 32 + 8 * fq;
        const float sc = (t == 0) ? QSCALE : 1.f;
        const bool kv = (t == 1 || t == 2);
        float* fp = out + (t == 1 ? O_KP : O_VP); float* fs = out + (t == 1 ? O_KS : O_VS);
        const int row0 = u.pm * BM + wr * 64 + fr;
#pragma unroll
        for (int ai = 0; ai < 2; ++ai)
#pragma unroll
            for (int m = 0; m < 4; ++m) {
                const int row = row0 + ai * HALF + m * 16;
                bf16_t* rowp = base + (size_t)row * 512 + col0;
                float* fo = nullptr;
                if (kv) { if (row < MP) fo = fp + (size_t)row * 512 + col0; else if (row < MP + MS) fo = fs + (size_t)(row - MP) * 512 + col0; }
#pragma unroll
                for (int bj = 0; bj < 2; ++bj) {
                    const f32x4 v0 = acc[ai][bj][m][0] * sc, v1 = acc[ai][bj][m][1] * sc;
                    *(u32x4*)(rowp + bj * HALF) = pack8(v0, v1);
                    if (fo) { *(f32x4*)(fo + bj * HALF) = v0; *(f32x4*)(fo + bj * HALF + 4) = v1; }
                }
            }
    }
};
struct EpiOut {
    static constexpr bool PERM = true, AFTER_DRAIN = false;
    const float* xp; const float* xs; const float* mod; const float* gm2; float* X1; bf16_t* A2; float* SS;
    __device__ __forceinline__ void operator()(const f32x4 (&acc)[2][2][4][2], const Unit& u, int wr, int wc, int fr, int fq) const {
        const int col0 = u.pn * BM + wc * 32 + 8 * fq;
        const int row0 = u.pm * BM + wr * 64 + fr;
#pragma unroll
        for (int ai = 0; ai < 2; ++ai) {
            if (u.pm == 256 && ai == 1) continue;
#pragma unroll
            for (int m = 0; m < 4; ++m) {
                const int row = row0 + ai * HALF + m * 16;
                const int mr = (u.pm < 256) ? (u.pm >> 4) : 16 + 4 * wr + m;
                const float* xr = (row < MP) ? xp + (size_t)row * 1024 : xs + (size_t)(row - MP) * 1024;
                const float* gt = mod + (size_t)mr * 6144 + 2048; const float* gm = gm2 + (size_t)mr * 1024;
                float s = 0.f;
#pragma unroll
                for (int bj = 0; bj < 2; ++bj) {
                    const int c = col0 + bj * HALF;
                    const f32x4 xa = *(const f32x4*)(xr + c), xb = *(const f32x4*)(xr + c + 4);
                    const f32x4 ga = *(const f32x4*)(gt + c), gb = *(const f32x4*)(gt + c + 4);
                    const f32x4 ma = *(const f32x4*)(gm + c), mb = *(const f32x4*)(gm + c + 4);
                    const f32x4 r0 = xa + ga * acc[ai][bj][m][0], r1 = xb + gb * acc[ai][bj][m][1];
                    *(f32x4*)(X1 + (size_t)row * 1024 + c) = r0; *(f32x4*)(X1 + (size_t)row * 1024 + c + 4) = r1;
                    s += sumsq4(r0) + sumsq4(r1);
                    *(u32x4*)(A2 + (size_t)row * 1024 + c) = pack8(r0 * ma, r1 * mb);
                }
                s += __shfl_xor(s, 16); s += __shfl_xor(s, 32);
                if (fq == 0) SS[(size_t)row * 16 + u.pn * 4 + wc] = s;
            }
        }
    }
};
struct EpiUp {
    static constexpr bool PERM = true, AFTER_DRAIN = false;
    const float* SS; const float* BU; bf16_t* H;
    __device__ __forceinline__ void operator()(const f32x4 (&acc)[2][2][4][2], const Unit& u, int wr, int wc, int fr, int fq) const {
        const int col0 = u.pn * BM + wc * 32 + 8 * fq;
        const int row0 = u.pm * BM + wr * 64 + fr;
#pragma unroll
        for (int ai = 0; ai < 2; ++ai)
#pragma unroll
            for (int m = 0; m < 4; ++m) {
                const int row = row0 + ai * HALF + m * 16;
                const int mr = (u.pm < 256) ? (u.pm >> 4) : (ai == 0 ? 16 + 4 * wr + m : 16);
                const f32x4* sp = (const f32x4*)(SS + (size_t)row * 16);
                const f32x4 s4 = (sp[0] + sp[1]) + (sp[2] + sp[3]);
                const float rstd = 1.0f / sqrtf(((s4[0] + s4[1]) + (s4[2] + s4[3])) * (1.0f / 1024.0f) + NORM_EPS);
                const float* bu = BU + (size_t)mr * 4096;
#pragma unroll
                for (int bj = 0; bj < 2; ++bj) {
                    const int c = col0 + bj * HALF;
                    const f32x4 b0 = *(const f32x4*)(bu + c), b1 = *(const f32x4*)(bu + c + 4);
                    f32x4 v0 = acc[ai][bj][m][0] * rstd + b0, v1 = acc[ai][bj][m][1] * rstd + b1;
#pragma unroll
                    for (int j = 0; j < 4; ++j) { const float a = fmaxf(v0[j], 0.f), b = fmaxf(v1[j], 0.f); v0[j] = a * a; v1[j] = b * b; }
                    *(u32x4*)(H + (size_t)row * 4096 + c) = pack8(v0, v1);
                }
            }
    }
};
struct EpiDown {
    static constexpr bool PERM = true, AFTER_DRAIN = false;
    const float* mod; float* X1;
    __device__ __forceinline__ void operator()(const f32x4 (&acc)[2][2][4][2], const Unit& u, int wr, int wc, int fr, int fq) const {
        const int col0 = u.pn * BM + wc * 32 + 8 * fq;
        const int row0 = u.pm * BM + wr * 64 + fr;
#pragma unroll
        for (int ai = 0; ai < 2; ++ai) {
            if (u.pm == 256 && ai == 1) continue;
#pragma unroll
            for (int m = 0; m < 4; ++m) {
                const int row = row0 + ai * HALF + m * 16;
                const int mr = (u.pm < 256) ? (u.pm >> 4) : 16 + 4 * wr + m;
                const float* gt = mod + (size_t)mr * 6144 + 5120;
                float* xr = X1 + (size_t)row * 1024;
#pragma unroll
                for (int bj = 0; bj < 2; ++bj) {
                    const int c = col0 + bj * HALF;
                    const f32x4 xa = *(const f32x4*)(xr + c), xb = *(const f32x4*)(xr + c + 4);
                    const f32x4 ga = *(const f32x4*)(gt + c), gb = *(const f32x4*)(gt + c + 4);
                    *(f32x4*)(xr + c) = xa + ga * acc[ai][bj][m][0]; *(f32x4*)(xr + c + 4) = xb + gb * acc[ai][bj][m][1];
                }
            }
        }
    }
};

template <class Epi, class Sched, bool ALIGN_EPI = false, bool SP2 = false>
__device__ __forceinline__ void gemm_phase(PG8_LAS unsigned char* lds, const Gemm g, const Sched& S, const Epi& E) {
    int tid_ = threadIdx.x; asm volatile("" : "+v"(tid_));
    const int tid = tid_, wid = __builtin_amdgcn_readfirstlane(tid >> 6), lane = tid & 63, wr = wid >> 2, wc = wid & 3, fr = lane & 15, fq = lane >> 4;
    const int K = g.K, nt = K / BK;
    unsigned voffA[2], voffB[2];
#pragma unroll
    for (int i = 0; i < 2; ++i) { int R, C; stage_rc(tid * 16 + i * 8192, R, C); const int Rb = Epi::PERM ? ((R & ~31) + perm32(R & 31)) : R;
        voffA[i] = (unsigned)(R * K + C) * 2u; voffB[i] = (unsigned)(Rb * K + C) * 2u; }
    const size_t kstep = (size_t)(BK * 2);
    const size_t hstep = (size_t)HALF * K * 2;
    const size_t tstep = 2 * hstep;
    const unsigned ldsw = (unsigned)wid * 1024u;
    const int aoff = lds_byte(wr * 64 + fr, fq * 8), boff = lds_byte(wc * 32 + fr, fq * 8);
#define PG8_SA(b, h) (((b) * 2 + (h)) * HTB)
#define PG8_SB(b, h) ((4 + (b) * 2 + (h)) * HTB)
#define PG8_STAGE(bufoff, gbase, voff) do { _Pragma("unroll") for (int _i = 0; _i < 2; ++_i) \
        __builtin_amdgcn_global_load_lds((const unsigned*)((const char*)(gbase) + (voff)[_i]), (PG8_LAS unsigned*)(lds + (bufoff) + ldsw + _i * 8192), 16, 0, 0); } while (0)
#define PG8_LDA(dst, b, h) do { _Pragma("unroll") for (int m = 0; m < 4; ++m) _Pragma("unroll") for (int k = 0; k < 2; ++k) dst[m][k] = *(const PG8_LAS bf16x8*)(lds + PG8_SA(b, h) + aoff + m * 2048 + k * 1024); } while (0)
#define PG8_LDB(dst, b, h) do { _Pragma("unroll") for (int n = 0; n < 2; ++n) _Pragma("unroll") for (int k = 0; k < 2; ++k) dst[n][k] = *(const PG8_LAS bf16x8*)(lds + PG8_SB(b, h) + boff + n * 2048 + k * 1024); } while (0)
#define PG8_MMA(ai, bj, At, Bt) do { __builtin_amdgcn_s_setprio(1); _Pragma("unroll") for (int m = 0; m < 4; ++m) _Pragma("unroll") for (int n = 0; n < 2; ++n) _Pragma("unroll") for (int k = 0; k < 2; ++k) \
        acc[ai][bj][m][n] = __builtin_amdgcn_mfma_f32_16x16x32_bf16(Bt[n][k], At[m][k], acc[ai][bj][m][n], 0, 0, 0); __builtin_amdgcn_s_setprio(0); } while (0)
#define PG8_WAIT_V(n) asm volatile("s_waitcnt vmcnt(" #n ")" ::: "memory")
#define PG8_WAIT_L(n) asm volatile("s_waitcnt lgkmcnt(" #n ")" ::: "memory")
#define PG8_BAR __builtin_amdgcn_s_barrier()
#define PG8_SCHED __builtin_amdgcn_sched_barrier(0)
    Unit cur, nxt; int ui = 0;
    if (!S.next(0, cur)) return;
    f32x4 acc[2][2][4][2];
#pragma unroll
    for (int a = 0; a < 2; ++a)
#pragma unroll
        for (int b = 0; b < 2; ++b)
#pragma unroll
            for (int m = 0; m < 4; ++m)
#pragma unroll
                for (int n = 0; n < 2; ++n) acc[a][b][m][n] = (f32x4){0.f, 0.f, 0.f, 0.f};
    bf16x8 At[4][2], B0[2][2], B1[2][2];
    const char* cA = (const char*)g.A + (size_t)cur.pm * tstep; const char* cB = (const char*)g.Bt + (size_t)cur.pn * tstep;
    S.a_ready(cur);
    if constexpr (SP2) {
        PG8_STAGE(PG8_SB(0, 0), cB, voffB); PG8_STAGE(PG8_SB(0, 1), cB + hstep, voffB); PG8_STAGE(PG8_SA(0, 0), cA, voffA); PG8_STAGE(PG8_SA(0, 1), cA + hstep, voffA);
        if (wr == 1) PG8_BAR;
        PG8_WAIT_V(2); PG8_BAR;
        PG8_STAGE(PG8_SB(1, 0), cB + kstep, voffB); PG8_STAGE(PG8_SA(1, 0), cA + kstep, voffA); PG8_STAGE(PG8_SB(1, 1), cB + hstep + kstep, voffB);
        PG8_WAIT_V(6); PG8_BAR;
    } else {
        PG8_STAGE(PG8_SB(0, 0), cB, voffB); PG8_STAGE(PG8_SA(0, 0), cA, voffA); PG8_STAGE(PG8_SB(0, 1), cB + hstep, voffB); PG8_STAGE(PG8_SA(0, 1), cA + hstep, voffA);
        if (wr == 1) PG8_BAR;
        PG8_WAIT_V(4); PG8_BAR;
        PG8_STAGE(PG8_SB(1, 0), cB + kstep, voffB); PG8_STAGE(PG8_SA(1, 0), cA + kstep, voffA); PG8_STAGE(PG8_SB(1, 1), cB + hstep + kstep, voffB);
        PG8_WAIT_V(6); PG8_BAR;
    }
    for (;;) {
        const bool has_next = S.next(ui + 1, nxt);
        const char* nA = has_next ? (const char*)g.A + (size_t)nxt.pm * tstep : cA; const char* nB = has_next ? (const char*)g.Bt + (size_t)nxt.pn * tstep : cB;
        for (int t = 0; t < nt; t += 2) {
            const bool last = (t == nt - 2);
            const char* a1 = cA + (size_t)(t + 1) * kstep;
            const char* a2 = last ? nA : cA + (size_t)(t + 2) * kstep; const char* b2 = last ? nB : cB + (size_t)(t + 2) * kstep;
            const char* a3 = a2 + kstep; const char* b3 = b2 + kstep;
            if (last && has_next) S.a_ready(nxt);
            if constexpr (SP2) {
            PG8_LDB(B0, 0, 0); PG8_LDB(B1, 0, 1); PG8_SCHED; PG8_LDA(At, 0, 0); PG8_STAGE(PG8_SA(1, 1), a1 + hstep, voffA);
            PG8_WAIT_V(8); PG8_WAIT_L(0); PG8_BAR; PG8_MMA(0, 0, At, B0); PG8_MMA(0, 1, At, B1); PG8_BAR; PG8_SCHED;
            PG8_LDA(At, 0, 1); PG8_STAGE(PG8_SB(0, 0), b2, voffB); PG8_STAGE(PG8_SB(0, 1), b2 + hstep, voffB); PG8_STAGE(PG8_SA(0, 0), a2, voffA);
            PG8_WAIT_V(8); PG8_WAIT_L(0); PG8_BAR; PG8_MMA(1, 0, At, B0); PG8_MMA(1, 1, At, B1); PG8_BAR; PG8_SCHED;
            PG8_LDB(B0, 1, 0); PG8_LDB(B1, 1, 1); PG8_SCHED; PG8_LDA(At, 1, 0); PG8_STAGE(PG8_SA(0, 1), a2 + hstep, voffA);
            PG8_WAIT_V(8); PG8_WAIT_L(0); PG8_BAR; PG8_MMA(0, 0, At, B0); PG8_MMA(0, 1, At, B1); PG8_BAR; PG8_SCHED;
            PG8_LDA(At, 1, 1); PG8_STAGE(PG8_SB(1, 0), b3, voffB); PG8_STAGE(PG8_SB(1, 1), b3 + hstep, voffB); PG8_STAGE(PG8_SA(1, 0), a3, voffA);
            PG8_WAIT_V(8); PG8_WAIT_L(0); PG8_BAR; PG8_MMA(1, 0, At, B0); PG8_MMA(1, 1, At, B1); PG8_BAR; PG8_SCHED;
            } else {
            PG8_LDB(B0, 0, 0); PG8_SCHED; PG8_LDA(At, 0, 0); PG8_STAGE(PG8_SA(1, 1), a1 + hstep, voffA);
            PG8_WAIT_L(8); PG8_BAR; PG8_WAIT_L(0); PG8_MMA(0, 0, At, B0); PG8_BAR; PG8_SCHED;
            PG8_LDB(B1, 0, 1); PG8_STAGE(PG8_SB(0, 0), b2, voffB);
            PG8_BAR; PG8_WAIT_L(0); PG8_MMA(0, 1, At, B1); PG8_BAR;
            PG8_LDA(At, 0, 1); PG8_STAGE(PG8_SA(0, 0), a2, voffA);
            PG8_BAR; PG8_WAIT_L(0); PG8_MMA(1, 0, At, B0); PG8_BAR; PG8_SCHED;
            PG8_STAGE(PG8_SB(0, 1), b2 + hstep, voffB);
            PG8_WAIT_V(6); PG8_BAR; PG8_MMA(1, 1, At, B1); PG8_BAR;
            PG8_LDB(B0, 1, 0); PG8_SCHED; PG8_LDA(At, 1, 0); PG8_STAGE(PG8_SA(0, 1), a2 + hstep, voffA);
            PG8_WAIT_L(8); PG8_BAR; PG8_WAIT_L(0); PG8_MMA(0, 0, At, B0); PG8_BAR; PG8_SCHED;
            PG8_LDB(B1, 1, 1); PG8_STAGE(PG8_SB(1, 0), b3, voffB);
            PG8_BAR; PG8_WAIT_L(0); PG8_MMA(0, 1, At, B1); PG8_BAR;
            PG8_LDA(At, 1, 1); PG8_STAGE(PG8_SA(1, 0), a3, voffA);
            PG8_BAR; PG8_WAIT_L(0); PG8_MMA(1, 0, At, B0); PG8_BAR; PG8_SCHED;
            PG8_STAGE(PG8_SB(1, 1), b3 + hstep, voffB);
            PG8_WAIT_V(6); PG8_BAR; PG8_MMA(1, 1, At, B1); PG8_BAR;
            }
        }
        if constexpr (ALIGN_EPI) { if (wr == 0) PG8_BAR; }
        if constexpr (!Epi::AFTER_DRAIN) { E(acc, cur, wr, wc, fr, fq); S.done(cur); }
        if (!has_next) break;
#pragma unroll
        for (int a = 0; a < 2; ++a)
#pragma unroll
            for (int b = 0; b < 2; ++b)
#pragma unroll
                for (int m = 0; m < 4; ++m)
#pragma unroll
                    for (int n = 0; n < 2; ++n) acc[a][b][m][n] = (f32x4){0.f, 0.f, 0.f, 0.f};
        cur = nxt; cA = nA; cB = nB; ++ui;
        if constexpr (ALIGN_EPI) { if (wr == 1) PG8_BAR; }
    }
    PG8_WAIT_V(0);
    if constexpr (!ALIGN_EPI) { if (wr == 0) PG8_BAR; }
    PG8_BAR;
    if constexpr (Epi::AFTER_DRAIN) { E.fused(acc, cur, wr, wc, fr, fq, lds, wid, lane); S.done(cur); }
#undef PG8_SA
#undef PG8_SB
#undef PG8_STAGE
#undef PG8_LDA
#undef PG8_LDB
#undef PG8_MMA
#undef PG8_WAIT_V
#undef PG8_WAIT_L
#undef PG8_BAR
#undef PG8_SCHED
}
}

#define LAS __attribute__((address_space(3)))
typedef unsigned short bf16;
typedef float f32x4 __attribute__((ext_vector_type(4)));
typedef unsigned u32x4 __attribute__((ext_vector_type(4)));
typedef unsigned u32x2 __attribute__((ext_vector_type(2)));
typedef short bf16x8 __attribute__((ext_vector_type(8)));
typedef short s16x4 __attribute__((ext_vector_type(4)));
typedef float f32x16 __attribute__((ext_vector_type(16)));
#define LDS_WAIT() asm volatile("s_waitcnt lgkmcnt(0)" ::: "memory")
__device__ __forceinline__ float wave_sum(float v) {
#pragma unroll
    for (int o = 1; o < 64; o <<= 1) v += __shfl_xor(v, o);
    return v;
}
__device__ __forceinline__ float wave_max(float v) {
#pragma unroll
    for (int o = 1; o < 64; o <<= 1) v = fmaxf(v, __shfl_xor(v, o));
    return v;
}
__device__ __forceinline__ float bf2f(unsigned b) { return __uint_as_float(b << 16); }
__device__ __forceinline__ unsigned f2bf(float f) { unsigned u = __float_as_uint(f); return (u + 0x7fffu + ((u >> 16) & 1u)) >> 16; }
__device__ __forceinline__ unsigned pk2(float lo, float hi) { return pg8::cvt_pk_bf16(lo, hi); }
__device__ __forceinline__ void unpack8(const u32x4 w, float (&v)[8]) {
    v[0] = bf2f(w.x & 0xffffu); v[1] = __uint_as_float(w.x & 0xffff0000u); v[2] = bf2f(w.y & 0xffffu); v[3] = __uint_as_float(w.y & 0xffff0000u);
    v[4] = bf2f(w.z & 0xffffu); v[5] = __uint_as_float(w.z & 0xffff0000u); v[6] = bf2f(w.w & 0xffffu); v[7] = __uint_as_float(w.w & 0xffff0000u);
}
__device__ __forceinline__ u32x4 pack8f(const float (&v)[8]) { u32x4 w; w.x = pk2(v[0], v[1]); w.y = pk2(v[2], v[3]); w.z = pk2(v[4], v[5]); w.w = pk2(v[6], v[7]); return w; }

struct Args { const float* in[23]; float* out; unsigned char* ws; };
enum { I_XP = 0, I_XS, I_CK, I_CV, I_CLF, I_CCONV, I_CP, I_CS, I_WADA, I_BADA, I_G1, I_G2, I_WIN, I_BF, I_WCONV, I_GATT, I_GCONV, I_WOUT, I_WUP, I_WDN, I_WADAF, I_BADAF, I_GF };

constexpr int NWAVES = 8, NTHR = 512;
constexpr int RING_BYTES = 131072, LDS_BYTES = 147456;

__device__ __forceinline__ void gemv24_group(const LAS float* A, LAS float* red, const float* W, int pitch, int col0, const float* bias, float* out, int opitch, int tid) {
    const int c = tid & 31, kg = tid >> 5;
    float acc[24];
#pragma unroll
    for (int r = 0; r < 24; ++r) acc[r] = 0.f;
    const float* wp = W + (size_t)(kg * 64) * pitch + col0 + c;
    const LAS float* ap = A + kg * 64;
#pragma unroll 2
    for (int k4 = 0; k4 < 16; ++k4) {
        const float w0 = wp[0], w1 = wp[pitch], w2 = wp[2 * (size_t)pitch], w3 = wp[3 * (size_t)pitch]; wp += 4 * (size_t)pitch;
#pragma unroll
        for (int r = 0; r < 24; ++r) { const f32x4 a = *(const LAS f32x4*)(ap + r * 1024 + k4 * 4); acc[r] += (a[0] * w0 + a[1] * w1) + (a[2] * w2 + a[3] * w3); }
    }
#pragma unroll
    for (int r = 0; r < 24; ++r) acc[r] += __shfl_xor(acc[r], 32);
    const int wid = tid >> 6, lane = tid & 63;
    if (lane < 32) {
#pragma unroll
        for (int r = 0; r < 24; ++r) red[(wid * 24 + r) * 32 + c] = acc[r];
    }
    __syncthreads();
    for (int o = tid; o < 768; o += NTHR) {
        const int r = o >> 5, cc = o & 31; float s = 0.f;
#pragma unroll
        for (int w = 0; w < 8; ++w) s += red[(w * 24 + r) * 32 + cc];
        if (bias) s += bias[col0 + cc];
        out[(size_t)r * opitch + col0 + cc] = s;
    }
    __syncthreads();
}

__device__ __forceinline__ void transpose_item(const float* W, int pitch, int K, bf16* WT, int k0, int nsrc0, int ndst0, LAS float* scr, int lane) {
#pragma unroll 8
    for (int i = 0; i < 32; ++i) { const int kk = 2 * i + (lane >> 5); scr[kk * 33 + (lane & 31)] = W[(size_t)(k0 + kk) * pitch + nsrc0 + (lane & 31)]; }
    LDS_WAIT(); asm volatile("" ::: "memory");
    const int c = lane & 7;
#pragma unroll
    for (int j = 0; j < 4; ++j) { const int n = (lane >> 3) + 8 * j; const LAS float* s = scr + (8 * c) * 33 + n;
        u32x4 o; o.x = pk2(s[0 * 33], s[1 * 33]); o.y = pk2(s[2 * 33], s[3 * 33]); o.z = pk2(s[4 * 33], s[5 * 33]); o.w = pk2(s[6 * 33], s[7 * 33]);
        *(u32x4*)(WT + (size_t)(ndst0 + n) * K + k0 + 8 * c) = o; }
    LDS_WAIT(); asm volatile("" ::: "memory");
}

namespace att {
constexpr int SEQ = 4096, D = 64, DM = 512, QB = 256, QBLK = 32, KVBLK = 64, NW = 8;
constexpr int SLOTB = 8192;
constexpr int LDS_K = 0, LDS_V = 2 * SLOTB, LDS_WS = 4 * SLOTB, LDS_OST = LDS_WS + 2048, LDS_F = LDS_OST + NW * 4096, LDS_END = LDS_F + 16384;
static_assert(LDS_END <= RING_BYTES, "attention LDS");
__device__ __forceinline__ int crow(int r, int hi) { return (r & 3) + 8 * (r >> 2) + 4 * hi; }
__device__ __forceinline__ void cmask(f32x16& p0, f32x16& p1, int jb, int qrel, int hi) {
    const float NEG = -INFINITY; const int kb = 64 * jb + 4 * hi;
#pragma unroll
    for (int r = 0; r < 16; ++r) { const int kv = kb + (r & 3) + 8 * (r >> 2); if (kv > qrel) p0[r] = NEG; if (kv + 32 > qrel) p1[r] = NEG; }
}
__device__ __forceinline__ void glds16(const void* gsrc, unsigned lds_dst) { unsigned keep;
    asm volatile("s_mov_b32 %0, m0\n\ts_mov_b32 m0, %2\n\ts_nop 0\n\tglobal_load_lds_dwordx4 %1, off\n\ts_mov_b32 m0, %0" : "=&s"(keep) : "v"(gsrc), "s"(lds_dst) : "memory"); }
__device__ __forceinline__ float max3f(float a, float b, float c) { return fmaxf(fmaxf(a, b), c); }
__device__ __forceinline__ float rowmax(const f32x16& p0, const f32x16& p1) {
    float a = max3f(p0[0], p0[1], p1[0]), b = max3f(p0[2], p0[3], p1[1]); a = max3f(a, p1[2], p1[3]);
#pragma unroll
    for (int r = 4; r < 16; r += 4) { a = max3f(a, p0[r], p0[r + 1]); b = max3f(b, p0[r + 2], p0[r + 3]); a = max3f(a, p1[r], p1[r + 1]); b = max3f(b, p1[r + 2], p1[r + 3]); }
    const float m = fmaxf(a, b);
    auto rr = __builtin_amdgcn_permlane32_swap(__float_as_uint(m), __float_as_uint(m), false, false);
    return fmaxf(__uint_as_float(rr[0]), __uint_as_float(rr[1]));
}
#define ATT_WAIT_BAR0() asm volatile("s_waitcnt vmcnt(0) lgkmcnt(0)\n\ts_barrier" ::: "memory")
__device__ __forceinline__ void qkt(f32x16& p0, f32x16& p1, const LAS char* Kslot, const bf16x8* qr, const f32x16& cin, int r32, int hi) {
    const LAS char* kb = Kslot + hi * 1024 + r32 * 16;
#pragma unroll
    for (int d0 = 0; d0 < 4; ++d0) {
        const bf16x8 b0 = *(const LAS bf16x8*)(kb + d0 * 2048);
        const bf16x8 b1 = *(const LAS bf16x8*)(kb + d0 * 2048 + 512);
        if (d0 == 0) { p0 = __builtin_amdgcn_mfma_f32_32x32x16_bf16(b0, qr[0], cin, 0, 0, 0); p1 = __builtin_amdgcn_mfma_f32_32x32x16_bf16(b1, qr[0], cin, 0, 0, 0); }
        else { p0 = __builtin_amdgcn_mfma_f32_32x32x16_bf16(b0, qr[d0], p0, 0, 0, 0); p1 = __builtin_amdgcn_mfma_f32_32x32x16_bf16(b1, qr[d0], p1, 0, 0, 0); }
    }
}
__device__ __forceinline__ void pv(f32x16* o, int vb, bf16x8 pa0, bf16x8 pa1, bf16x8 pa2, bf16x8 pa3) {
#pragma unroll
    for (int d0 = 0; d0 < 2; ++d0) { s16x4 lo[4], hi[4];
#pragma unroll
        for (int ks = 0; ks < 4; ++ks) {
            asm volatile("ds_read_b64_tr_b16 %0,%1 offset:%c2" : "=&v"(lo[ks]) : "v"(vb), "i"(d0 * 4096 + ks * 1024) : "memory");
            asm volatile("ds_read_b64_tr_b16 %0,%1 offset:%c2" : "=&v"(hi[ks]) : "v"(vb), "i"(d0 * 4096 + ks * 1024 + 512) : "memory"); }
        asm volatile("s_waitcnt lgkmcnt(0)" ::: "memory"); __builtin_amdgcn_sched_barrier(0);
#define ATT_PK(k) (bf16x8){lo[k][0], lo[k][1], lo[k][2], lo[k][3], hi[k][0], hi[k][1], hi[k][2], hi[k][3]}
        o[d0] = __builtin_amdgcn_mfma_f32_32x32x16_bf16(pa0, ATT_PK(0), o[d0], 0, 0, 0);
        o[d0] = __builtin_amdgcn_mfma_f32_32x32x16_bf16(pa1, ATT_PK(1), o[d0], 0, 0, 0);
        o[d0] = __builtin_amdgcn_mfma_f32_32x32x16_bf16(pa2, ATT_PK(2), o[d0], 0, 0, 0);
        o[d0] = __builtin_amdgcn_mfma_f32_32x32x16_bf16(pa3, ATT_PK(3), o[d0], 0, 0, 0);
#undef ATT_PK
    }
}
__device__ __forceinline__ void attn_unit(int b, int h, int qb, const bf16* Q, const bf16* __restrict__ K, const bf16* __restrict__ V, bf16* O, const float* __restrict__ F2g, LAS char* shm) {
    int tid_ = threadIdx.x; asm volatile("" : "+v"(tid_));
    const int tid = tid_, lane = tid & 63, r32 = lane & 31, hi = lane >> 5; const int wid = __builtin_amdgcn_readfirstlane(tid >> 6);
    const long rowbase = (long)b * SEQ; const int q0 = qb * QB;
    const bf16* Qw = Q + (rowbase + q0 + wid * QBLK) * DM + h * D;
    const bf16* Kh = K + rowbase * DM + h * D, *Vh = V + rowbase * DM + h * D;
    const unsigned lds0 = (unsigned)(uintptr_t)shm;
    LAS float* wsf = (LAS float*)(shm + LDS_WS) + wid * 64;
    LAS float* Fl = (LAS float*)(shm + LDS_F);
    const bf16* ksrc = Kh + (long)lane * DM + wid * 8;
    const bf16* vsrc = Vh + (long)(16 * (wid & 3) + (lane >> 2)) * DM + (wid >> 2) * 32 + (lane & 3) * 8;
    const unsigned kdst = lds0 + LDS_K + wid * 1024, vdst = lds0 + LDS_V + wid * 1024;
#define DMA_K(t, slot) glds16(ksrc + (long)(t) * KVBLK * DM, (unsigned)__builtin_amdgcn_readfirstlane(kdst + (slot)))
#define DMA_V(t, slot) glds16(vsrc + (long)(t) * KVBLK * DM, (unsigned)__builtin_amdgcn_readfirstlane(vdst + (slot)))
    const int vb0 = (int)(lds0 + LDS_V) + ((lane >> 4) & 1) * 32 + (lane & 3) * 8 + (4 * hi + ((lane & 15) >> 2)) * 64;
    const int NT = (q0 + QB) / KVBLK;
    DMA_K(0, 0); DMA_V(0, 0);
    for (int i = tid; i < NT * 64; i += NTHR) Fl[i] = F2g[i];
    bf16x8 qr[4];
#pragma unroll
    for (int d0 = 0; d0 < 4; ++d0) qr[d0] = *reinterpret_cast<const bf16x8*>(&Qw[(long)r32 * DM + d0 * 16 + hi * 8]);
    const float fqv = F2g[q0 + wid * QBLK + r32];
    f32x16 cin;
#pragma unroll
    for (int r = 0; r < 16; ++r) cin[r] = fqv;
    float mref = 0.f, l_reg = 0.f; f32x16 o[2];
#pragma unroll
    for (int r = 0; r < 16; ++r) { o[0][r] = 0.f; o[1][r] = 0.f; }
    const int qrel = wid * QBLK + r32;
    for (int t = 0; t < NT; ++t) {
        const int slot = (t & 1) * SLOTB;
        ATT_WAIT_BAR0();
        if (t + 1 < NT) { DMA_K(t + 1, slot ^ SLOTB); DMA_V(t + 1, slot ^ SLOTB); }
        const int jb = t - (NT - 4);
        if (jb >= 0 && 64 * jb > wid * QBLK + 31) continue;
        f32x16 p0, p1;
        qkt(p0, p1, (const LAS char*)(shm + LDS_K + slot), qr, cin, r32, hi);
#pragma unroll
        for (int g = 0; g < 4; ++g) {
            const f32x4 f0 = *(const LAS f32x4*)(Fl + 64 * t + 8 * g + 4 * hi), f1 = *(const LAS f32x4*)(Fl + 64 * t + 32 + 8 * g + 4 * hi);
#pragma unroll
            for (int j = 0; j < 4; ++j) { p0[4 * g + j] -= f0[j]; p1[4 * g + j] -= f1[j]; }
        }
        if (jb >= 0) cmask(p0, p1, jb, qrel, hi);
        const float rm = rowmax(p0, p1);
        bool resc = false;
        if (t == 0 || __any(rm > 8.0f)) {
            const float dl = (t == 0) ? rm : fmaxf(rm, 0.f);
            mref += dl;
#pragma unroll
            for (int r = 0; r < 16; ++r) { p0[r] -= dl; p1[r] -= dl; }
#pragma unroll
            for (int r = 0; r < 16; ++r) cin[r] = fqv - mref;
            if (t != 0) { const float f = __builtin_amdgcn_exp2f(-dl); l_reg *= f; if (hi == 0) wsf[r32] = f; resc = true; }
        }
        float sacc = 0.f;
#pragma unroll
        for (int r = 0; r < 16; ++r) { p0[r] = __builtin_amdgcn_exp2f(p0[r]); p1[r] = __builtin_amdgcn_exp2f(p1[r]); sacc += p0[r] + p1[r]; }
        l_reg += sacc;
        u32x4 pw0, pw1, pw2, pw3;
        pw0 = (u32x4){pk2(p0[0], p0[1]), pk2(p0[2], p0[3]), pk2(p0[4], p0[5]), pk2(p0[6], p0[7])};
        pw1 = (u32x4){pk2(p0[8], p0[9]), pk2(p0[10], p0[11]), pk2(p0[12], p0[13]), pk2(p0[14], p0[15])};
        pw2 = (u32x4){pk2(p1[0], p1[1]), pk2(p1[2], p1[3]), pk2(p1[4], p1[5]), pk2(p1[6], p1[7])};
        pw3 = (u32x4){pk2(p1[8], p1[9]), pk2(p1[10], p1[11]), pk2(p1[12], p1[13]), pk2(p1[14], p1[15])};
        if (resc) {
            LDS_WAIT();
#pragma unroll
            for (int r = 0; r < 16; ++r) { const float f = wsf[crow(r, hi)]; o[0][r] *= f; o[1][r] *= f; }
        }
        pv(o, vb0 + slot, __builtin_bit_cast(bf16x8, pw0), __builtin_bit_cast(bf16x8, pw1), __builtin_bit_cast(bf16x8, pw2), __builtin_bit_cast(bf16x8, pw3));
    }
    { auto rr = __builtin_amdgcn_permlane32_swap(__float_as_uint(l_reg), __float_as_uint(l_reg), false, false); l_reg = __uint_as_float(rr[0]) + __uint_as_float(rr[1]); }
    if (hi == 0) wsf[32 + r32] = l_reg; LDS_WAIT();
    float rli[16];
#pragma unroll
    for (int r = 0; r < 16; ++r) rli[r] = __builtin_amdgcn_rcpf(wsf[32 + crow(r, hi)]);
    bf16* Ow = O + (rowbase + q0 + wid * QBLK) * DM + h * D;
    { LAS bf16* stg = (LAS bf16*)(shm + LDS_OST) + wid * 2048;
#pragma unroll
      for (int r = 0; r < 16; ++r) { const int orow = crow(r, hi);
#pragma unroll
        for (int d0 = 0; d0 < 2; ++d0) stg[orow * 64 + d0 * 32 + r32] = (bf16)f2bf(o[d0][r] * rli[r]); }
      LDS_WAIT();
#pragma unroll
      for (int i = 0; i < 4; ++i) { const int row = i * 8 + (lane >> 3), ch = lane & 7; const u32x4 v = *(const LAS u32x4*)(stg + row * 64 + ch * 8); *(u32x4*)(Ow + (long)row * DM + ch * 8) = v; } }
    asm volatile("s_waitcnt vmcnt(0) lgkmcnt(0)\n\ts_barrier" ::: "memory");
#undef DMA_K
#undef DMA_V
}
}

__device__ __forceinline__ void attn_sample_unit(int b, int h, int sp, const Args& a, LAS char* shm) {
    const int tid = threadIdx.x, lane = tid & 63; const int wid = __builtin_amdgcn_readfirstlane(tid >> 6);
    LAS float* qs = (LAS float*)shm;
    LAS float* ps = (LAS float*)(shm + 4096) + wid * 1024;
    LAS float* red = (LAS float*)(shm + 4096 + 32768);
    const bf16* Qb = (const bf16*)(a.ws + R1_Q) + (size_t)(MP + 16 * b) * 512 + h * 64;
    for (int i = tid; i < 1024; i += NTHR) qs[i] = bf2f(Qb[(i >> 6) * 512 + (i & 63)]);
    const float* F = (const float*)(a.ws + WS_FSS) + (size_t)(b * 8 + h) * 4112;
    __syncthreads();
    float m[16], ll[16], o[16];
#pragma unroll
    for (int i = 0; i < 16; ++i) { m[i] = -1e30f; ll[i] = 0.f; o[i] = 0.f; }
    const int nch = (sp == 3 && wid == 0) ? 3 : 2;
    for (int ch = 0; ch < nch; ++ch) {
        int key0, nvalid; const float* kbase; const float* vbase;
        if (ch < 2) { key0 = 1024 * sp + 128 * wid + 64 * ch; nvalid = 64; const size_t off = ((size_t)(b * 4096 + key0) * 8 + h) * 64; kbase = a.in[I_CK] + off; vbase = a.in[I_CV] + off; }
        else { key0 = 4096; nvalid = 16; const size_t off = ((size_t)(b * 16) * 8 + h) * 64; kbase = a.out + O_KS + off; vbase = a.out + O_VS + off; }
        const bool valid = lane < nvalid; const int key = key0 + lane;
        const float* kp = kbase + (size_t)(valid ? lane : 0) * 512;
        float s[16];
#pragma unroll
        for (int i = 0; i < 16; ++i) s[i] = 0.f;
#pragma unroll 4
        for (int d4 = 0; d4 < 16; ++d4) {
            const f32x4 kk = *(const f32x4*)(kp + 4 * d4);
#pragma unroll
            for (int i = 0; i < 16; ++i) { const f32x4 q4 = *(const LAS f32x4*)(qs + i * 64 + 4 * d4); s[i] += (q4[0] * kk[0] + q4[1] * kk[1]) + (q4[2] * kk[2] + q4[3] * kk[3]); }
        }
        const float fk = F[valid ? key : 0];
#pragma unroll
        for (int i = 0; i < 16; ++i) {
            float sv = s[i] + (F[4096 + i] - fk);
            if (!valid || key > 4096 + i) sv = -INFINITY;
            const float cm = wave_max(sv), mn = fmaxf(m[i], cm), al = __builtin_amdgcn_exp2f(m[i] - mn), p = __builtin_amdgcn_exp2f(sv - mn);
            ll[i] = ll[i] * al + p; o[i] *= al; m[i] = mn; s[i] = p;
        }
#pragma unroll
        for (int i4 = 0; i4 < 4; ++i4) *(LAS f32x4*)(ps + lane * 16 + 4 * i4) = (f32x4){s[4 * i4], s[4 * i4 + 1], s[4 * i4 + 2], s[4 * i4 + 3]};
        LDS_WAIT();
#pragma unroll 4
        for (int k = 0; k < nvalid; ++k) {
            const float v = vbase[(size_t)k * 512 + lane];
#pragma unroll
            for (int i4 = 0; i4 < 4; ++i4) { const f32x4 p4 = *(const LAS f32x4*)(ps + k * 16 + 4 * i4);
                o[4 * i4] += p4[0] * v; o[4 * i4 + 1] += p4[1] * v; o[4 * i4 + 2] += p4[2] * v; o[4 * i4 + 3] += p4[3] * v; }
        }
        LDS_WAIT();
    }
#pragma unroll
    for (int i = 0; i < 16; ++i) ll[i] = wave_sum(ll[i]);
#pragma unroll
    for (int i = 0; i < 16; ++i) red[(wid * 16 + i) * 66 + lane] = o[i];
    if (lane == 0) {
#pragma unroll
        for (int i = 0; i < 16; ++i) { red[(wid * 16 + i) * 66 + 64] = m[i]; red[(wid * 16 + i) * 66 + 65] = ll[i]; }
    }
    __syncthreads();
    {
        const int i = tid >> 5, dd = tid & 31;
        float M = -1e30f;
#pragma unroll
        for (int w = 0; w < 8; ++w) M = fmaxf(M, red[(w * 16 + i) * 66 + 64]);
        float L = 0.f, O0 = 0.f, O1 = 0.f;
#pragma unroll
        for (int w = 0; w < 8; ++w) { const float f = __builtin_amdgcn_exp2f(red[(w * 16 + i) * 66 + 64] - M); L += red[(w * 16 + i) * 66 + 65] * f; O0 += red[(w * 16 + i) * 66 + dd] * f; O1 += red[(w * 16 + i) * 66 + dd + 32] * f; }
        float* pp = (float*)(a.ws + WS_PART) + ((size_t)((b * 8 + h) * 4 + sp) * 16 + i) * 66;
        pp[dd] = O0; pp[dd + 32] = O1; if (dd == 0) { pp[64] = M; pp[65] = L; }
    }
    __syncthreads();
}

__device__ __forceinline__ void scan_seq(int seq, const Args& a, LAS float* sm) {
    const int tid = threadIdx.x, lane = tid & 63, wid = tid >> 6;
    const bool smp = seq >= 128; const int s = smp ? seq - 128 : seq; const int b = s >> 3, h = s & 7;
    const float* src = smp ? a.in[I_CLF] + (size_t)(b * 4096) * 8 + h : a.out + O_LP + (size_t)(b * 4096) * 8 + h;
    float v[8]; float run = 0.f;
#pragma unroll
    for (int i = 0; i < 8; ++i) { run += src[(size_t)(tid * 8 + i) * 8]; v[i] = run; }
    float inc = run;
#pragma unroll
    for (int o = 1; o < 64; o <<= 1) { const float t = __shfl_up(inc, o); if (lane >= o) inc += t; }
    if (lane == 63) sm[wid] = inc;
    __syncthreads();
    float off = inc - run;
    for (int w = 0; w < wid; ++w) off += sm[w];
    float* dst = smp ? (float*)(a.ws + WS_FSS) + (size_t)s * 4112 : (float*)(a.ws + WS_FS) + (size_t)s * 4096;
#pragma unroll
    for (int i = 0; i < 8; ++i) dst[tid * 8 + i] = (off + v[i]) * LOG2E;
    if (smp && tid == NTHR - 1) {
        float r2 = off + v[7];
        for (int i = 0; i < 16; ++i) { r2 += a.out[O_LS + (size_t)(b * 16 + i) * 8 + h]; dst[4096 + i] = r2 * LOG2E; }
    }
    __syncthreads();
}

__device__ __forceinline__ f32x4 thin_gemm(const bf16* A, int lda, const bf16* Bt, int ldb, int kbeg, int klen, int n0, int wave, int lane) {
    const int fr = lane & 15, fq = lane >> 4;
    const bf16* ap = A + (size_t)(16 * wave + fr) * lda + kbeg + 8 * fq;
    const bf16* bp = Bt + (size_t)(n0 + fr) * ldb + kbeg + 8 * fq;
    f32x4 acc0 = {0.f, 0.f, 0.f, 0.f}, acc1 = {0.f, 0.f, 0.f, 0.f};
#pragma unroll 4
    for (int k = 0; k < klen; k += 64) {
        const bf16x8 a0 = *(const bf16x8*)(ap + k), b0 = *(const bf16x8*)(bp + k), a1 = *(const bf16x8*)(ap + k + 32), b1 = *(const bf16x8*)(bp + k + 32);
        acc0 = __builtin_amdgcn_mfma_f32_16x16x32_bf16(b0, a0, acc0, 0, 0, 0);
        acc1 = __builtin_amdgcn_mfma_f32_16x16x32_bf16(b1, a1, acc1, 0, 0, 0);
    }
    return acc0 + acc1;
}

__global__ void __launch_bounds__(NTHR, 2) hymba_fwd(Args a) {
    extern __shared__ __attribute__((aligned(16))) unsigned char lds_raw[];
    LAS unsigned char* lds = (LAS unsigned char*)lds_raw;
    cg::grid_group grid = cg::this_grid();
    const int tid = threadIdx.x, lane = tid & 63; const int wave = __builtin_amdgcn_readfirstlane(tid >> 6);
    const int G = gridDim.x, bx = blockIdx.x;
    const int vcu = (G % 8 == 0) ? (bx % 8) * (G / 8) + bx / 8 : bx;
    const int gw = vcu * NWAVES + wave, NGW = G * NWAVES;
    unsigned char* ws = a.ws;
    float* mod = (float*)(ws + WS_MOD); float* modf = (float*)(ws + WS_MODF); float* gm2 = (float*)(ws + WS_GM2); float* BU = (float*)(ws + WS_BU);
    bf16* Win_t = (bf16*)(ws + WS_WIN); bf16* Wout_t = (bf16*)(ws + WS_WOUT); bf16* Wup_t = (bf16*)(ws + WS_WUP); bf16* Wdn_t = (bf16*)(ws + WS_WDN);
    bf16* XN = (bf16*)(ws + R1_XN); bf16* QB = (bf16*)(ws + R1_Q); bf16* Hb = (bf16*)(ws + WS_R1);
    float* SST = (float*)(ws + WS_SST);
    float* X1 = (float*)(ws + WS_X1); bf16* A2 = (bf16*)(ws + WS_A2); float* SS = (float*)(ws + WS_SS);

    {
        LAS float* A = (LAS float*)lds; LAS float* red = (LAS float*)(lds + 98304);
        for (int i = tid; i < 24 * 1024; i += NTHR) { const int r = i >> 10, k = i & 1023; const float c = (r < 16) ? a.in[I_CP][r * 1024 + k] : a.in[I_CS][(r - 16) * 1024 + k]; A[i] = c / (1.f + __expf(-c)); }
        __syncthreads();
        for (int grp = bx; grp < 256; grp += G) {
            const int col = grp * 32;
            if (col < 6144) gemv24_group(A, red, a.in[I_WADA], 6144, col, a.in[I_BADA], mod, 6144, tid);
            else gemv24_group(A, red, a.in[I_WADAF], 2048, col - 6144, a.in[I_BADAF], modf, 2048, tid);
        }
        __syncthreads();
    }
    {
        LAS float* scr = (LAS float*)(lds + wave * 16384);
        constexpr int I_IN = 16 * 96, I_OUT = 16 * 32, I_UP = 16 * 128, I_DN = 64 * 32, NITEMS = I_IN + I_OUT + I_UP + I_DN;
        for (int it = gw; it < NITEMS; it += NGW) {
            int r = it;
            if (r < I_IN) { const int kb = r / 96, nb = r % 96; transpose_item(a.in[I_WIN], PROJ, 1024, Win_t, 64 * kb, 32 * nb + (nb >= 48 ? 8 : 0), 32 * nb, scr, lane); continue; } r -= I_IN;
            if (r < I_OUT) { const int kb = r / 32, nb = r % 32; transpose_item(a.in[I_WOUT], 1024, 1024, Wout_t, 64 * kb, 32 * nb, 32 * nb, scr, lane); continue; } r -= I_OUT;
            if (r < I_UP) { const int kb = r / 128, nb = r % 128; transpose_item(a.in[I_WUP], 4096, 1024, Wup_t, 64 * kb, 32 * nb, 32 * nb, scr, lane); continue; } r -= I_UP;
            { const int kb = r / 32, nb = r % 32; transpose_item(a.in[I_WDN], 1024, 4096, Wdn_t, 64 * kb, 32 * nb, 32 * nb, scr, lane); }
        }
    }
    grid.sync();
    {
        LAS float* WfT = (LAS float*)lds;
        for (int i = tid; i < 8192; i += NTHR) { const int hh = i & 7, k = i >> 3; WfT[hh * 1024 + k] = a.in[I_WIN][(size_t)k * PROJ + 1536 + hh]; }
        for (int i = bx * NTHR + tid; i < 24 * 1024; i += G * NTHR) { const int r = i >> 10, k = i & 1023; gm2[i] = a.in[I_G2][k] * (1.f + mod[(size_t)r * 6144 + 4096 + k]); }
        __syncthreads();
        f32x4 g1v[4];
#pragma unroll
        for (int j = 0; j < 4; ++j) g1v[j] = ((const f32x4*)a.in[I_G1])[lane + 64 * j];
        for (int row = gw; row < MPAD; row += NGW) {
            u32x2* xo = (u32x2*)(XN + (size_t)row * 1024) + lane;
            if (row >= MP + MS) {
#pragma unroll
                for (int j = 0; j < 4; ++j) xo[64 * j] = (u32x2){0u, 0u};
                continue;
            }
            const float* xr = (row < MP) ? a.in[I_XP] + (size_t)row * 1024 : a.in[I_XS] + (size_t)(row - MP) * 1024;
            const int mr = (row < MP) ? (row >> 12) : 16 + ((row - MP) >> 4);
            const f32x4* x4 = (const f32x4*)xr + lane; const f32x4* sh4 = (const f32x4*)(mod + (size_t)mr * 6144) + lane; const f32x4* sc4 = (const f32x4*)(mod + (size_t)mr * 6144 + 1024) + lane;
            f32x4 v[4]; float ss = 0.f;
#pragma unroll
            for (int j = 0; j < 4; ++j) { v[j] = x4[64 * j]; ss += (v[j][0] * v[j][0] + v[j][1] * v[j][1]) + (v[j][2] * v[j][2] + v[j][3] * v[j][3]); }
            const float rstd = 1.0f / sqrtf(wave_sum(ss) * (1.0f / 1024.0f) + NORM_EPS);
            float fl[8];
#pragma unroll
            for (int hh = 0; hh < 8; ++hh) fl[hh] = 0.f;
#pragma unroll
            for (int j = 0; j < 4; ++j) {
                const f32x4 hv = (v[j] * rstd) * g1v[j] * (sc4[64 * j] + 1.0f) + sh4[64 * j];
                xo[64 * j] = (u32x2){pk2(hv[0], hv[1]), pk2(hv[2], hv[3])};
#pragma unroll
                for (int hh = 0; hh < 8; ++hh) { const f32x4 w = *(const LAS f32x4*)(WfT + hh * 1024 + 4 * lane + 256 * j); fl[hh] += (hv[0] * w[0] + hv[1] * w[1]) + (hv[2] * w[2] + hv[3] * w[3]); }
            }
            float z = 0.f;
#pragma unroll
            for (int hh = 0; hh < 8; ++hh) { const float t = wave_sum(fl[hh]); z = (lane == hh) ? t : z; }
            if (lane < 8) {
                z += a.in[I_BF][lane];
                const float lf = fminf(z, 0.f) - log1pf(__expf(-fabsf(z)));
                if (row < MP) a.out[O_LP + (size_t)row * 8 + lane] = lf; else a.out[O_LS + (size_t)(row - MP) * 8 + lane] = lf;
            }
        }
    }
    grid.sync();
    {
        for (int seq = bx; seq < 192; seq += G) scan_seq(seq, a, (LAS float*)lds);
        __syncthreads();
        for (int slab = vcu; slab < NIN / 16; slab += G) {
            const int n0 = slab * 16, fr = lane & 15, fq = lane >> 4;
            const f32x4 acc = thin_gemm(XN + (size_t)MP * 1024, 1024, Win_t, 1024, 0, 1024, n0, wave, lane);
            const int c = n0 + 4 * fq, t = c >> 9, cc = c & 511, row = 16 * wave + fr;
            const f32x4 v = acc * ((t == 0) ? QSCALE : 1.f);
            *(u32x2*)(QB + (size_t)t * BUF512 + (size_t)(MP + row) * 512 + cc) = (u32x2){pk2(v[0], v[1]), pk2(v[2], v[3])};
            if (t == 1) *(f32x4*)(a.out + O_KS + (size_t)row * 512 + cc) = v;
            if (t == 2) *(f32x4*)(a.out + O_VS + (size_t)row * 512 + cc) = v;
        }
        pg8::Gemm g{XN, Win_t, MP, NIN, 1024}; pg8::StaticOrder S; S.init(MP, NIN, G, bx);
        pg8::EpiIn E{QB, a.out};
        pg8::gemm_phase<pg8::EpiIn, pg8::StaticOrder, true, true>(lds, g, S, E);
    }
    grid.sync();
    {
        const bf16* Qp = QB; const bf16* Kp = QB + BUF512; const bf16* Vp = QB + 2 * BUF512;
        for (int u = vcu; u < 256; u += G) attn_sample_unit(u >> 5, (u >> 2) & 7, u & 3, a, (LAS char*)lds);
#ifndef NO_ATT
        for (int u = vcu; u < 2048; u += G) {
            const int c = u & 255, i = u >> 8; const int bh = c >> 1, par = c & 1;
            const int k = 7 - i;
            const int qb = par ? ((k & 1) ? 4 * (k >> 1) + 2 : 4 * (k >> 1) + 1) : ((k & 1) ? 4 * (k >> 1) + 3 : 4 * (k >> 1));
            att::attn_unit(bh >> 3, bh & 7, qb, Qp, Kp, Vp, (bf16*)Qp, (const float*)(ws + WS_FS) + (size_t)bh * 4096, (LAS char*)lds);
        }
#endif
    }
    grid.sync();
    {
        {
            LAS float* A = (LAS float*)lds; LAS float* red = (LAS float*)(lds + 98304);
            if (bx < 128) {
                for (int i = tid; i < 24 * 1024; i += NTHR) { const int r = i >> 10, k = i & 1023; A[i] = mod[(size_t)r * 6144 + 3072 + k]; }
                __syncthreads();
                for (int grp = bx; grp < 128; grp += G) gemv24_group(A, red, a.in[I_WUP], 4096, grp * 32, nullptr, BU, 4096, tid);
            }
        }
        const bf16* Ob = QB; const bf16* BGb = QB + 3 * BUF512; const bf16* CGb = QB + 4 * BUF512; const bf16* Ub = QB + 5 * BUF512;
        bf16* MG = XN;
        const int c0 = 8 * lane;
        float gatt[8], gconv[8], w0[8], w1[8], w2[8];
#pragma unroll
        for (int j = 0; j < 8; ++j) { gatt[j] = a.in[I_GATT][c0 + j]; gconv[j] = a.in[I_GCONV][c0 + j]; w0[j] = a.in[I_WCONV][c0 + j]; w1[j] = a.in[I_WCONV][512 + c0 + j]; w2[j] = a.in[I_WCONV][1024 + c0 + j]; }
        for (int run = gw; run < 2048 + 8; run += NGW) {
            const bool smp = run >= 2048; const int bs = run - 2048;
            const int row0 = smp ? MP + bs * 16 : run * 32; const int nrows = smp ? 16 : 32;
            float um2[8], um1[8];
            if (smp) {
#pragma unroll
                for (int j = 0; j < 8; ++j) { um2[j] = a.in[I_CCONV][(size_t)(bs * 2) * 512 + c0 + j]; um1[j] = a.in[I_CCONV][(size_t)(bs * 2 + 1) * 512 + c0 + j]; }
            } else if ((row0 & 4095) == 0) {
#pragma unroll
                for (int j = 0; j < 8; ++j) { um2[j] = 0.f; um1[j] = 0.f; }
            } else {
                float ca[8], ua[8];
                unpack8(*(const u32x4*)(CGb + (size_t)(row0 - 2) * 512 + c0), ca); unpack8(*(const u32x4*)(Ub + (size_t)(row0 - 2) * 512 + c0), ua);
#pragma unroll
                for (int j = 0; j < 8; ++j) um2[j] = ca[j] * ua[j];
                unpack8(*(const u32x4*)(CGb + (size_t)(row0 - 1) * 512 + c0), ca); unpack8(*(const u32x4*)(Ub + (size_t)(row0 - 1) * 512 + c0), ua);
#pragma unroll
                for (int j = 0; j < 8; ++j) um1[j] = ca[j] * ua[j];
            }
            for (int rr = 0; rr < nrows; ++rr) {
                const int row = row0 + rr;
                float at[8];
                if (!smp) unpack8(*(const u32x4*)(Ob + (size_t)row * 512 + c0), at);
                else {
                    const int hh = lane >> 3, d0 = (lane & 7) * 8;
                    const float* pp = (const float*)(ws + WS_PART) + ((size_t)((bs * 8 + hh) * 4) * 16 + rr) * 66;
                    float M = -1e30f;
#pragma unroll
                    for (int sp = 0; sp < 4; ++sp) M = fmaxf(M, pp[(size_t)sp * 16 * 66 + 64]);
                    float L = 0.f;
#pragma unroll
                    for (int j = 0; j < 8; ++j) at[j] = 0.f;
#pragma unroll
                    for (int sp = 0; sp < 4; ++sp) { const float* q = pp + (size_t)sp * 16 * 66; const float f = __builtin_amdgcn_exp2f(q[64] - M); L += q[65] * f;
#pragma unroll
                        for (int j = 0; j < 8; ++j) at[j] += q[d0 + j] * f; }
                    const float rl = 1.0f / L;
#pragma unroll
                    for (int j = 0; j < 8; ++j) at[j] *= rl;
                }
                float ss = 0.f;
#pragma unroll
                for (int j = 0; j < 8; ++j) ss += at[j] * at[j];
                const float ra = 1.0f / sqrtf(wave_sum(ss) * (1.0f / 512.0f) + NORM_EPS);
#pragma unroll
                for (int j = 0; j < 8; ++j) at[j] = at[j] * ra * gatt[j];
                *(u32x4*)(MG + (size_t)row * 1024 + c0) = pack8f(at);
                float bgv[8], ca[8], ua[8], u8[8], y[8];
                unpack8(*(const u32x4*)(BGb + (size_t)row * 512 + c0), bgv); unpack8(*(const u32x4*)(CGb + (size_t)row * 512 + c0), ca); unpack8(*(const u32x4*)(Ub + (size_t)row * 512 + c0), ua);
                float s2 = 0.f;
#pragma unroll
                for (int j = 0; j < 8; ++j) { u8[j] = ca[j] * ua[j]; y[j] = bgv[j] * (w0[j] * um2[j] + w1[j] * um1[j] + w2[j] * u8[j]); s2 += y[j] * y[j]; }
                const float rc = 1.0f / sqrtf(wave_sum(s2) * (1.0f / 512.0f) + NORM_EPS);
#pragma unroll
                for (int j = 0; j < 8; ++j) y[j] = y[j] * rc * gconv[j];
                *(u32x4*)(MG + (size_t)row * 1024 + 512 + c0) = pack8f(y);
                if (!smp) { const int t = row & 4095; if (t >= 4094) { float* co = a.out + O_CP + (size_t)((row >> 12) * 2 + (t - 4094)) * 512 + c0;
#pragma unroll
                        for (int j = 0; j < 8; ++j) co[j] = u8[j]; } }
                else if (rr >= 14) { float* co = a.out + O_CS + (size_t)(bs * 2 + (rr - 14)) * 512 + c0;
#pragma unroll
                        for (int j = 0; j < 8; ++j) co[j] = u8[j]; }
#pragma unroll
                for (int j = 0; j < 8; ++j) { um2[j] = um1[j]; um1[j] = u8[j]; }
            }
        }
    }
    grid.sync();
    {
        for (int slab = vcu; slab < 64; slab += G) {
            const int n0 = slab * 16, fr = lane & 15, fq = lane >> 4;
            const f32x4 acc = thin_gemm(XN + (size_t)MP * 1024, 1024, Wout_t, 1024, 0, 1024, n0, wave, lane);
            const int c = n0 + 4 * fq, row = 16 * wave + fr, mr = 16 + wave;
            const f32x4 xv = *(const f32x4*)(a.in[I_XS] + (size_t)row * 1024 + c), gt = *(const f32x4*)(mod + (size_t)mr * 6144 + 2048 + c), gm = *(const f32x4*)(gm2 + (size_t)mr * 1024 + c);
            const f32x4 r0 = xv + gt * acc;
            *(f32x4*)(X1 + (size_t)(MP + row) * 1024 + c) = r0;
            const f32x4 am = r0 * gm;
            *(u32x2*)(A2 + (size_t)(MP + row) * 1024 + c) = (u32x2){pk2(am[0], am[1]), pk2(am[2], am[3])};
            float s = (r0[0] * r0[0] + r0[1] * r0[1]) + (r0[2] * r0[2] + r0[3] * r0[3]);
            s += __shfl_xor(s, 16); s += __shfl_xor(s, 32);
            if (fq == 0) SST[row * 64 + slab] = s;
        }
        pg8::Gemm g{XN, Wout_t, MP, 1024, 1024}; pg8::StaticOrder S; S.init(MP, 1024, G, bx);
        pg8::EpiOut E{a.in[I_XP], a.in[I_XS], mod, gm2, X1, A2, SS};
        pg8::gemm_phase<pg8::EpiOut, pg8::StaticOrder, true, true>(lds, g, S, E);
    }
    grid.sync();
    {
        for (int slab = vcu; slab < 256; slab += G) {
            const int n0 = slab * 16, fr = lane & 15, fq = lane >> 4;
            const int row = 16 * wave + fr, mr = 16 + wave;
            const f32x4* sp = (const f32x4*)(SST + row * 64 + 16 * fq);
            const f32x4 s4 = (sp[0] + sp[1]) + (sp[2] + sp[3]);
            float s = (s4[0] + s4[1]) + (s4[2] + s4[3]);
            s += __shfl_xor(s, 16); s += __shfl_xor(s, 32);
            const float rstd = 1.0f / sqrtf(s * (1.0f / 1024.0f) + NORM_EPS);
            const f32x4 acc = thin_gemm(A2 + (size_t)MP * 1024, 1024, Wup_t, 1024, 0, 1024, n0, wave, lane);
            const int c = n0 + 4 * fq;
            f32x4 v = acc * rstd + *(const f32x4*)(BU + (size_t)mr * 4096 + c);
#pragma unroll
            for (int j = 0; j < 4; ++j) { const float q = fmaxf(v[j], 0.f); v[j] = q * q; }
            *(u32x2*)(Hb + (size_t)(MP + row) * 4096 + c) = (u32x2){pk2(v[0], v[1]), pk2(v[2], v[3])};
        }
        pg8::Gemm g{A2, Wup_t, MP, FFD, 1024}; pg8::StaticOrder S; S.init(MP, FFD, G, bx);
        pg8::EpiUp E{SS, BU, Hb};
        pg8::gemm_phase<pg8::EpiUp, pg8::StaticOrder, true, true>(lds, g, S, E);
    }
    grid.sync();
    {
        for (int slab = vcu; slab < 256; slab += G) {
            const int n0 = (slab & 63) * 16, ks = slab >> 6, fr = lane & 15, fq = lane >> 4;
            const f32x4 acc = thin_gemm(Hb + (size_t)MP * 4096, 4096, Wdn_t, 4096, ks * 1024, 1024, n0, wave, lane);
            const int c = n0 + 4 * fq, row = 16 * wave + fr, mr = 16 + wave;
            const f32x4 gt = *(const f32x4*)(mod + (size_t)mr * 6144 + 5120 + c);
            float* xo = X1 + (size_t)(MP + row) * 1024 + c;
#pragma unroll
            for (int j = 0; j < 4; ++j) atomicAdd(xo + j, gt[j] * acc[j]);
        }
        pg8::Gemm g{Hb, Wdn_t, MP, 1024, FFD}; pg8::StaticOrder S; S.init(MP, 1024, G, bx);
        pg8::EpiDown E{mod, X1};
        pg8::gemm_phase<pg8::EpiDown, pg8::StaticOrder, true, true>(lds, g, S, E);
    }
    grid.sync();
    {
        f32x4 gfv[4];
#pragma unroll
        for (int j = 0; j < 4; ++j) gfv[j] = ((const f32x4*)a.in[I_GF])[lane + 64 * j];
        for (int row = gw; row < MP + MS; row += NGW) {
            const int mr = (row < MP) ? (row >> 12) : 16 + ((row - MP) >> 4);
            const f32x4* x4 = (const f32x4*)(X1 + (size_t)row * 1024) + lane;
            const f32x4* sh4 = (const f32x4*)(modf + (size_t)mr * 2048) + lane; const f32x4* sc4 = (const f32x4*)(modf + (size_t)mr * 2048 + 1024) + lane;
            f32x4* yo = (f32x4*)((row < MP) ? a.out + O_YP + (size_t)row * 1024 : a.out + O_YS + (size_t)(row - MP) * 1024) + lane;
            f32x4 v[4]; float ss = 0.f;
#pragma unroll
            for (int j = 0; j < 4; ++j) { v[j] = x4[64 * j]; ss += (v[j][0] * v[j][0] + v[j][1] * v[j][1]) + (v[j][2] * v[j][2] + v[j][3] * v[j][3]); }
            const float rstd = 1.0f / sqrtf(wave_sum(ss) * (1.0f / 1024.0f) + NORM_EPS);
#pragma unroll
            for (int j = 0; j < 4; ++j) yo[64 * j] = (v[j] * rstd) * gfv[j] * (sc4[64 * j] + 1.0f) + sh4[64 * j];
        }
    }
}

extern "C" void kernel_launch(void* const* d_in, const int* in_sizes, int n_in, void* d_out, int out_size, void* d_ws, size_t ws_size, hipStream_t stream) {
    static int grid = 0;
    if (grid == 0) {
        if (n_in != 23 || ws_size < WS_END) { fprintf(stderr, "kernel_launch: expected 23 inputs and >= %zu bytes of workspace; got %d, %zu\n", (size_t)WS_END, n_in, ws_size); grid = -1; return; }
        int dev = 0, cus = 0, per_cu = 0;
        hipGetDevice(&dev); hipDeviceGetAttribute(&cus, hipDeviceAttributeMultiprocessorCount, dev);
        hipFuncSetAttribute((const void*)hymba_fwd, hipFuncAttributeMaxDynamicSharedMemorySize, LDS_BYTES);
        hipOccupancyMaxActiveBlocksPerMultiprocessor(&per_cu, (const void*)hymba_fwd, NTHR, LDS_BYTES);
        if (per_cu < 1) { fprintf(stderr, "kernel_launch: occupancy query says %d blocks per CU\n", per_cu); per_cu = 1; }
        if (per_cu > 1) per_cu = 1;
        grid = cus * per_cu;
        (void)hipGetLastError();
    }
    if (grid < 0) return;
    Args a{};
    for (int i = 0; i < 23; ++i) a.in[i] = (const float*)d_in[i];
    a.out = (float*)d_out; a.ws = (unsigned char*)d_ws;
    void* params[] = {&a};
    hipError_t e = hipLaunchCooperativeKernel((const void*)hymba_fwd, dim3(grid), dim3(NTHR), params, LDS_BYTES, stream);
    if (e != hipSuccess) fprintf(stderr, "cooperative launch failed: %s (grid %d)\n", hipGetErrorString(e), grid);
}
```

```cpp
#include <hip/hip_runtime.h>
#include <hip/hip_cooperative_groups.h>
#include <cstdio>
#include <cstdint>
#include <cmath>
namespace cg = cooperative_groups;

constexpr int MP = 65536;
constexpr int MS = 128;
constexpr int MPAD = 65792;
constexpr int DMODEL = 1024, FFD = 4096, NIN = 3072, PROJ = 3080;
constexpr float NORM_EPS = 1e-6f;
constexpr float LOG2E = 1.4426950408889634f;
constexpr float QSCALE = 0.125f * 1.4426950408889634f;
constexpr size_t O_YP = 0, O_YS = 67108864, O_KP = 67239936, O_VP = 100794368, O_LP = 134348800, O_CP = 134873088,
                 O_KS = 134889472, O_VS = 134955008, O_LS = 135020544, O_CS = 135021568;
constexpr size_t MiB = 1u << 20;
constexpr size_t WS_WIN = 0, WS_WOUT = 6 * MiB, WS_WUP = 8 * MiB, WS_WDN = 16 * MiB;
constexpr size_t WS_MOD = 24 * MiB, WS_MODF = 24 * MiB + 640 * 1024, WS_GM2 = 24 * MiB + 896 * 1024, WS_BU = 25 * MiB;
constexpr size_t WS_SST = 25 * MiB + 512 * 1024;
constexpr size_t WS_FS = 26 * MiB, WS_FSS = 28 * MiB, WS_PART = 30 * MiB, WS_SS = 32 * MiB;
constexpr size_t WS_R1 = 40 * MiB;
constexpr size_t R1_XN = WS_R1, R1_Q = WS_R1 + (size_t)MPAD * 2048;
constexpr size_t BUF512 = (size_t)MPAD * 512;
constexpr size_t WS_X1 = WS_R1 + 514 * MiB;
constexpr size_t WS_A2 = WS_X1 + 257 * MiB;
constexpr size_t WS_END = WS_A2 + 129 * MiB;
static_assert((size_t)MPAD * 8192 == 514 * MiB, "H size");

namespace pg8 {
#define PG8_LAS __attribute__((address_space(3)))
typedef unsigned short bf16_t;
typedef short bf16x8 __attribute__((ext_vector_type(8)));
typedef float f32x4 __attribute__((ext_vector_type(4)));
typedef unsigned u32x4 __attribute__((ext_vector_type(4)));
constexpr int BM = 256, BK = 64, HALF = 128, HTB = HALF * BK * 2  , STAGE_BYTES = 8 * HTB, NXCD = 8, WGM = 8;

__host__ __device__ __forceinline__ int lds_byte(int r, int c) { const int st = (r >> 4) * 2 + (c >> 5), rr = r & 15, cc = c & 31, ob = rr * 64 + cc * 2; return st * 1024 + (ob ^ (((ob >> 9) & 1) << 5)); }
__host__ __device__ __forceinline__ void stage_rc(int b, int& R, int& C) { const int st = b / 1024, sb = b % 1024, swz = sb ^ (((sb >> 9) & 1) << 5); R = (st >> 1) * 16 + swz / 64; C = (st & 1) * 32 + (swz % 64) / 2; }
__host__ __device__ __forceinline__ int perm32(int rho) { const int n = rho >> 4, i = rho & 15; return 8 * (i >> 2) + 4 * n + (i & 3); }

struct Unit { int pm, pn; };
struct Gemm { const bf16_t* A; const bf16_t* Bt; int M, N, K; };

struct StaticOrder {
    int nM, nN, nwg, G, c;
    __host__ __device__ void init(int M, int N, int G_, int c_) { nM = M / BM; nN = N / BM; nwg = nM * nN; G = G_; c = c_; }
    __host__ __device__ bool next(int i, Unit& u) const {
        const long L = (long)i * G + c; if (L >= nwg) return false;
        int wgid = (int)L; { const int q = nwg / NXCD, r = nwg % NXCD, xcd = wgid % NXCD, off = wgid / NXCD; wgid = (xcd < r ? xcd * (q + 1) : r * (q + 1) + (xcd - r) * q) + off; }
        const int nig = WGM * nN, gid = wgid / nig, fm = gid * WGM, gsz = (nM - fm) < WGM ? (nM - fm) : WGM;
        u.pm = fm + ((wgid % nig) % gsz); u.pn = (wgid % nig) / gsz; return true;
    }
    __device__ __forceinline__ void a_ready(const Unit&) const {}
    __device__ __forceinline__ void done(const Unit&) const {}
};

__device__ __forceinline__ unsigned cvt_pk_bf16(float lo, float hi) { unsigned r; asm volatile("v_cvt_pk_bf16_f32 %0, %1, %2" : "=v"(r) : "v"(lo), "v"(hi)); return r; }
typedef float f32x2 __attribute__((ext_vector_type(2)));
__device__ __forceinline__ u32x4 pack8(const f32x4 v0, const f32x4 v1) { u32x4 w; w.x = cvt_pk_bf16(v0[0], v0[1]); w.y = cvt_pk_bf16(v0[2], v0[3]); w.z = cvt_pk_bf16(v1[0], v1[1]); w.w = cvt_pk_bf16(v1[2], v1[3]); return w; }
__device__ __forceinline__ float sumsq4(const f32x4 v) { return (v[0] * v[0] + v[1] * v[1]) + (v[2] * v[2] + v[3] * v[3]); }

struct EpiIn {
    static constexpr bool PERM = true, AFTER_DRAIN = false;
    bf16_t* QB; float* out;
    __device__ __forceinline__ void operator()(const f32x4 (&acc)[2][2][4][2], const Unit& u, int wr, int wc, int fr, int fq) const {
        const int t = u.pn >> 1;
        bf16_t* base = QB + (size_t)t * BUF512;
        const int col0 = (u.pn & 1) * 256 + wc * 32 + 8 * fq;
        const float sc = (t == 0) ? QSCALE : 1.f;
        const bool kv = (t == 1 || t == 2);
        float* fp = out + (t == 1 ? O_KP : O_VP);
        const int row0 = u.pm * BM + wr * 64 + fr;
#pragma unroll
        for (int ai = 0; ai < 2; ++ai)
#pragma unroll
            for (int m = 0; m < 4; ++m) {
                const int row = row0 + ai * HALF + m * 16;
                bf16_t* rowp = base + (size_t)row * 512 + col0;
                float* fo = nullptr;
                if (kv) fo = fp + (size_t)row * 512 + col0;
#pragma unroll
                for (int bj = 0; bj < 2; ++bj) {
                    const f32x4 v0 = acc[ai][bj][m][0] * sc, v1 = acc[ai][bj][m][1] * sc;
                    *(u32x4*)(rowp + bj * HALF) = pack8(v0, v1);
                    if (fo) { *(f32x4*)(fo + bj * HALF) = v0; *(f32x4*)(fo + bj * HALF + 4) = v1; }
                }
            }
    }
};
struct EpiOut {
    static constexpr bool PERM = true, AFTER_DRAIN = false;
    const float* xp; const float* mod; const float* gm2; float* X1; bf16_t* A2; float* SS;
    __device__ __forceinline__ void operator()(const f32x4 (&acc)[2][2][4][2], const Unit& u, int wr, int wc, int fr, int fq) const {
        const int col0 = u.pn * BM + wc * 32 + 8 * fq;
        const int row0 = u.pm * BM + wr * 64 + fr;
        const int mr = u.pm >> 4;
        const float* gt = mod + (size_t)mr * 6144 + 2048 + col0; const float* gm = gm2 + (size_t)mr * 1024 + col0;
        f32x4 gtv[2][2], gmv[2][2];
#pragma unroll
        for (int bj = 0; bj < 2; ++bj) { gtv[bj][0] = *(const f32x4*)(gt + bj * HALF); gtv[bj][1] = *(const f32x4*)(gt + bj * HALF + 4); gmv[bj][0] = *(const f32x4*)(gm + bj * HALF); gmv[bj][1] = *(const f32x4*)(gm + bj * HALF + 4); }
#pragma unroll
        for (int ai = 0; ai < 2; ++ai)
#pragma unroll
            for (int m = 0; m < 4; ++m) {
                const int row = row0 + ai * HALF + m * 16;
                const float* xr = xp + (size_t)row * 1024 + col0;
                f32x4 xv[2][2];
#pragma unroll
                for (int bj = 0; bj < 2; ++bj) { xv[bj][0] = *(const f32x4*)(xr + bj * HALF); xv[bj][1] = *(const f32x4*)(xr + bj * HALF + 4); }
                float s = 0.f;
#pragma unroll
                for (int bj = 0; bj < 2; ++bj) {
                    const int c = col0 + bj * HALF;
                    const f32x4 r0 = xv[bj][0] + gtv[bj][0] * acc[ai][bj][m][0], r1 = xv[bj][1] + gtv[bj][1] * acc[ai][bj][m][1];
                    *(f32x4*)(X1 + (size_t)row * 1024 + c) = r0; *(f32x4*)(X1 + (size_t)row * 1024 + c + 4) = r1;
                    s += sumsq4(r0) + sumsq4(r1);
                    *(u32x4*)(A2 + (size_t)row * 1024 + c) = pack8(r0 * gmv[bj][0], r1 * gmv[bj][1]);
                }
                s += __shfl_xor(s, 16); s += __shfl_xor(s, 32);
                if (fq == 0) SS[(size_t)row * 16 + u.pn * 4 + wc] = s;
            }
    }
};
struct EpiUp {
    static constexpr bool PERM = true, AFTER_DRAIN = false;
    const float* SS; const float* BU; bf16_t* H; PG8_LAS float* rtab;
    __device__ __forceinline__ void operator()(const f32x4 (&acc)[2][2][4][2], const Unit& u, int wr, int wc, int fr, int fq) const {
        const int col0 = u.pn * BM + wc * 32 + 8 * fq;
        const int row0 = u.pm * BM + wr * 64 + fr;
        { const int t = (wr * 4 + wc) * 64 + fq * 16 + fr;
          if (t < 256) { const f32x4* sp = (const f32x4*)(SS + (size_t)(u.pm * BM + t) * 16); const f32x4 s4 = (sp[0] + sp[1]) + (sp[2] + sp[3]);
              rtab[t] = 1.0f / sqrtf(((s4[0] + s4[1]) + (s4[2] + s4[3])) * (1.0f / 1024.0f) + NORM_EPS); } }
        const float* bu = BU + (size_t)(u.pm >> 4) * 4096 + col0;
        f32x4 bv[2][2];
#pragma unroll
        for (int bj = 0; bj < 2; ++bj) { bv[bj][0] = *(const f32x4*)(bu + bj * HALF); bv[bj][1] = *(const f32x4*)(bu + bj * HALF + 4); }
        asm volatile("s_waitcnt lgkmcnt(0)" ::: "memory"); __builtin_amdgcn_s_barrier(); asm volatile("" ::: "memory");
#pragma unroll
        for (int ai = 0; ai < 2; ++ai)
#pragma unroll
            for (int m = 0; m < 4; ++m) {
                const int row = row0 + ai * HALF + m * 16;
                const float rstd = rtab[ai * HALF + wr * 64 + m * 16 + fr];
#pragma unroll
                for (int bj = 0; bj < 2; ++bj) {
                    const int c = col0 + bj * HALF;
                    f32x4 v0 = acc[ai][bj][m][0] * rstd + bv[bj][0], v1 = acc[ai][bj][m][1] * rstd + bv[bj][1];
#pragma unroll
                    for (int j = 0; j < 4; ++j) { const float a = fmaxf(v0[j], 0.f), b = fmaxf(v1[j], 0.f); v0[j] = a * a; v1[j] = b * b; }
                    *(u32x4*)(H + (size_t)row * 4096 + c) = pack8(v0, v1);
                }
            }
    }
};
struct EpiDown {
    static constexpr bool PERM = true, AFTER_DRAIN = false;
    const float* mod; float* X1;
    __device__ __forceinline__ void operator()(const f32x4 (&acc)[2][2][4][2], const Unit& u, int wr, int wc, int fr, int fq) const {
        const int col0 = u.pn * BM + wc * 32 + 8 * fq;
        const int row0 = u.pm * BM + wr * 64 + fr;
        const float* gt = mod + (size_t)(u.pm >> 4) * 6144 + 5120 + col0;
        f32x4 gtv[2][2];
#pragma unroll
        for (int bj = 0; bj < 2; ++bj) { gtv[bj][0] = *(const f32x4*)(gt + bj * HALF); gtv[bj][1] = *(const f32x4*)(gt + bj * HALF + 4); }
#pragma unroll
        for (int ai = 0; ai < 2; ++ai)
#pragma unroll
            for (int m = 0; m < 4; ++m) {
                float* xr = X1 + (size_t)(row0 + ai * HALF + m * 16) * 1024 + col0;
                f32x4 xv[2][2];
#pragma unroll
                for (int bj = 0; bj < 2; ++bj) { xv[bj][0] = *(const f32x4*)(xr + bj * HALF); xv[bj][1] = *(const f32x4*)(xr + bj * HALF + 4); }
#pragma unroll
                for (int bj = 0; bj < 2; ++bj) { *(f32x4*)(xr + bj * HALF) = xv[bj][0] + gtv[bj][0] * acc[ai][bj][m][0]; *(f32x4*)(xr + bj * HALF + 4) = xv[bj][1] + gtv[bj][1] * acc[ai][bj][m][1]; }
            }
    }
};

template <class Epi, class Sched, bool ALIGN_EPI = false, bool SP2 = false>
__device__ __forceinline__ void gemm_phase(PG8_LAS unsigned char* lds, const Gemm g, const Sched& S, const Epi& E) {
    int tid_ = threadIdx.x; asm volatile("" : "+v"(tid_));
    const int tid = tid_, wid = __builtin_amdgcn_readfirstlane(tid >> 6), lane = tid & 63, wr = wid >> 2, wc = wid & 3, fr = lane & 15, fq = lane >> 4;
    const int K = g.K, nt = K / BK;
    unsigned voffA[2], voffB[2];
#pragma unroll
    for (int i = 0; i < 2; ++i) { int R, C; stage_rc(tid * 16 + i * 8192, R, C); const int Rb = Epi::PERM ? ((R & ~31) + perm32(R & 31)) : R;
        voffA[i] = (unsigned)(R * K + C) * 2u; voffB[i] = (unsigned)(Rb * K + C) * 2u; }
    const size_t kstep = (size_t)(BK * 2);
    const size_t hstep = (size_t)HALF * K * 2;
    const size_t tstep = 2 * hstep;
    const unsigned ldsw = (unsigned)wid * 1024u;
    const int aoff = lds_byte(wr * 64 + fr, fq * 8), boff = lds_byte(wc * 32 + fr, fq * 8);
#define PG8_SA(b, h) (((b) * 2 + (h)) * HTB)
#define PG8_SB(b, h) ((4 + (b) * 2 + (h)) * HTB)
#define PG8_STAGE(bufoff, gbase, voff) do { _Pragma("unroll") for (int _i = 0; _i < 2; ++_i) \
        __builtin_amdgcn_global_load_lds((const unsigned*)((const char*)(gbase) + (voff)[_i]), (PG8_LAS unsigned*)(lds + (bufoff) + ldsw + _i * 8192), 16, 0, 0); } while (0)
#define PG8_LDA(dst, b, h) do { _Pragma("unroll") for (int m = 0; m < 4; ++m) _Pragma("unroll") for (int k = 0; k < 2; ++k) dst[m][k] = *(const PG8_LAS bf16x8*)(lds + PG8_SA(b, h) + aoff + m * 2048 + k * 1024); } while (0)
#define PG8_LDB(dst, b, h) do { _Pragma("unroll") for (int n = 0; n < 2; ++n) _Pragma("unroll") for (int k = 0; k < 2; ++k) dst[n][k] = *(const PG8_LAS bf16x8*)(lds + PG8_SB(b, h) + boff + n * 2048 + k * 1024); } while (0)
#define PG8_MMA(ai, bj, At, Bt) do { __builtin_amdgcn_s_setprio(1); _Pragma("unroll") for (int m = 0; m < 4; ++m) _Pragma("unroll") for (int n = 0; n < 2; ++n) _Pragma("unroll") for (int k = 0; k < 2; ++k) \
        acc[ai][bj][m][n] = __builtin_amdgcn_mfma_f32_16x16x32_bf16(Bt[n][k], At[m][k], acc[ai][bj][m][n], 0, 0, 0); __builtin_amdgcn_s_setprio(0); } while (0)
#define PG8_WAIT_V(n) asm volatile("s_waitcnt vmcnt(" #n ")" ::: "memory")
#define PG8_WAIT_L(n) asm volatile("s_waitcnt lgkmcnt(" #n ")" ::: "memory")
#define PG8_BAR __builtin_amdgcn_s_barrier()
#define PG8_SCHED __builtin_amdgcn_sched_barrier(0)
    Unit cur, nxt; int ui = 0;
    if (!S.next(0, cur)) return;
    f32x4 acc[2][2][4][2];
#pragma unroll
    for (int a = 0; a < 2; ++a)
#pragma unroll
        for (int b = 0; b < 2; ++b)
#pragma unroll
            for (int m = 0; m < 4; ++m)
#pragma unroll
                for (int n = 0; n < 2; ++n) acc[a][b][m][n] = (f32x4){0.f, 0.f, 0.f, 0.f};
    bf16x8 At[4][2], B0[2][2], B1[2][2];
    const char* cA = (const char*)g.A + (size_t)cur.pm * tstep; const char* cB = (const char*)g.Bt + (size_t)cur.pn * tstep;
    S.a_ready(cur);
    if constexpr (SP2) {
        PG8_STAGE(PG8_SB(0, 0), cB, voffB); PG8_STAGE(PG8_SB(0, 1), cB + hstep, voffB); PG8_STAGE(PG8_SA(0, 0), cA, voffA); PG8_STAGE(PG8_SA(0, 1), cA + hstep, voffA);
        if (wr == 1) PG8_BAR;
        PG8_WAIT_V(2); PG8_BAR;
        PG8_STAGE(PG8_SB(1, 0), cB + kstep, voffB); PG8_STAGE(PG8_SA(1, 0), cA + kstep, voffA); PG8_STAGE(PG8_SB(1, 1), cB + hstep + kstep, voffB);
        PG8_WAIT_V(6); PG8_BAR;
    } else {
        PG8_STAGE(PG8_SB(0, 0), cB, voffB); PG8_STAGE(PG8_SA(0, 0), cA, voffA); PG8_STAGE(PG8_SB(0, 1), cB + hstep, voffB); PG8_STAGE(PG8_SA(0, 1), cA + hstep, voffA);
        if (wr == 1) PG8_BAR;
        PG8_WAIT_V(4); PG8_BAR;
        PG8_STAGE(PG8_SB(1, 0), cB + kstep, voffB); PG8_STAGE(PG8_SA(1, 0), cA + kstep, voffA); PG8_STAGE(PG8_SB(1, 1), cB + hstep + kstep, voffB);
        PG8_WAIT_V(6); PG8_BAR;
    }
    for (;;) {
        const bool has_next = S.next(ui + 1, nxt);
        const char* nA = has_next ? (const char*)g.A + (size_t)nxt.pm * tstep : cA; const char* nB = has_next ? (const char*)g.Bt + (size_t)nxt.pn * tstep : cB;
        for (int t = 0; t < nt; t += 2) {
            const bool last = (t == nt - 2);
            const char* a1 = cA + (size_t)(t + 1) * kstep;
            const char* a2 = last ? nA : cA + (size_t)(t + 2) * kstep; const char* b2 = last ? nB : cB + (size_t)(t + 2) * kstep;
            const char* a3 = a2 + kstep; const char* b3 = b2 + kstep;
            if (last && has_next) S.a_ready(nxt);
            if constexpr (SP2) {
            PG8_LDB(B0, 0, 0); PG8_LDB(B1, 0, 1); PG8_SCHED; PG8_LDA(At, 0, 0); PG8_STAGE(PG8_SA(1, 1), a1 + hstep, voffA);
            PG8_WAIT_V(8); PG8_WAIT_L(0); PG8_BAR; PG8_MMA(0, 0, At, B0); PG8_MMA(0, 1, At, B1); PG8_BAR; PG8_SCHED;
            PG8_LDA(At, 0, 1); PG8_STAGE(PG8_SB(0, 0), b2, voffB); PG8_STAGE(PG8_SB(0, 1), b2 + hstep, voffB); PG8_STAGE(PG8_SA(0, 0), a2, voffA);
            PG8_WAIT_V(8); PG8_WAIT_L(0); PG8_BAR; PG8_MMA(1, 0, At, B0); PG8_MMA(1, 1, At, B1); PG8_BAR; PG8_SCHED;
            PG8_LDB(B0, 1, 0); PG8_LDB(B1, 1, 1); PG8_SCHED; PG8_LDA(At, 1, 0); PG8_STAGE(PG8_SA(0, 1), a2 + hstep, voffA);
            PG8_WAIT_V(8); PG8_WAIT_L(0); PG8_BAR; PG8_MMA(0, 0, At, B0); PG8_MMA(0, 1, At, B1); PG8_BAR; PG8_SCHED;
            PG8_LDA(At, 1, 1); PG8_STAGE(PG8_SB(1, 0), b3, voffB); PG8_STAGE(PG8_SB(1, 1), b3 + hstep, voffB); PG8_STAGE(PG8_SA(1, 0), a3, voffA);
            PG8_WAIT_V(8); PG8_WAIT_L(0); PG8_BAR; PG8_MMA(1, 0, At, B0); PG8_MMA(1, 1, At, B1); PG8_BAR; PG8_SCHED;
            } else {
            PG8_LDB(B0, 0, 0); PG8_SCHED; PG8_LDA(At, 0, 0); PG8_STAGE(PG8_SA(1, 1), a1 + hstep, voffA);
            PG8_WAIT_L(8); PG8_BAR; PG8_WAIT_L(0); PG8_MMA(0, 0, At, B0); PG8_BAR; PG8_SCHED;
            PG8_LDB(B1, 0, 1); PG8_STAGE(PG8_SB(0, 0), b2, voffB);
            PG8_BAR; PG8_WAIT_L(0); PG8_MMA(0, 1, At, B1); PG8_BAR;
            PG8_LDA(At, 0, 1); PG8_STAGE(PG8_SA(0, 0), a2, voffA);
            PG8_BAR; PG8_WAIT_L(0); PG8_MMA(1, 0, At, B0); PG8_BAR; PG8_SCHED;
            PG8_STAGE(PG8_SB(0, 1), b2 + hstep, voffB);
            PG8_WAIT_V(6); PG8_BAR; PG8_MMA(1, 1, At, B1); PG8_BAR;
            PG8_LDB(B0, 1, 0); PG8_SCHED; PG8_LDA(At, 1, 0); PG8_STAGE(PG8_SA(0, 1), a2 + hstep, voffA);
            PG8_WAIT_L(8); PG8_BAR; PG8_WAIT_L(0); PG8_MMA(0, 0, At, B0); PG8_BAR; PG8_SCHED;
            PG8_LDB(B1, 1, 1); PG8_STAGE(PG8_SB(1, 0), b3, voffB);
            PG8_BAR; PG8_WAIT_L(0); PG8_MMA(0, 1, At, B1); PG8_BAR;
            PG8_LDA(At, 1, 1); PG8_STAGE(PG8_SA(1, 0), a3, voffA);
            PG8_BAR; PG8_WAIT_L(0); PG8_MMA(1, 0, At, B0); PG8_BAR; PG8_SCHED;
            PG8_STAGE(PG8_SB(1, 1), b3 + hstep, voffB);
            PG8_WAIT_V(6); PG8_BAR; PG8_MMA(1, 1, At, B1); PG8_BAR;
            }
        }
        if constexpr (ALIGN_EPI) { if (wr == 0) PG8_BAR; }
        if constexpr (!Epi::AFTER_DRAIN) { E(acc, cur, wr, wc, fr, fq); S.done(cur); }
        if (!has_next) break;
#pragma unroll
        for (int a = 0; a < 2; ++a)
#pragma unroll
            for (int b = 0; b < 2; ++b)
#pragma unroll
                for (int m = 0; m < 4; ++m)
#pragma unroll
                    for (int n = 0; n < 2; ++n) acc[a][b][m][n] = (f32x4){0.f, 0.f, 0.f, 0.f};
        cur = nxt; cA = nA; cB = nB; ++ui;
        if constexpr (ALIGN_EPI) { if (wr == 1) PG8_BAR; }
    }
    PG8_WAIT_V(0);
    if constexpr (!ALIGN_EPI) { if (wr == 0) PG8_BAR; }
    PG8_BAR;
    if constexpr (Epi::AFTER_DRAIN) { E.fused(acc, cur, wr, wc, fr, fq, lds, wid, lane); S.done(cur); }
#undef PG8_SA
#undef PG8_SB
#undef PG8_STAGE
#undef PG8_LDA
#undef PG8_LDB
#undef PG8_MMA
#undef PG8_WAIT_V
#undef PG8_WAIT_L
#undef PG8_BAR
#undef PG8_SCHED
}
}

#define LAS __attribute__((address_space(3)))
typedef unsigned short bf16;
typedef float f32x4 __attribute__((ext_vector_type(4)));
typedef unsigned u32x4 __attribute__((ext_vector_type(4)));
typedef unsigned u32x2 __attribute__((ext_vector_type(2)));
typedef short bf16x8 __attribute__((ext_vector_type(8)));
typedef short s16x4 __attribute__((ext_vector_type(4)));
typedef float f32x16 __attribute__((ext_vector_type(16)));
#define LDS_WAIT() asm volatile("s_waitcnt lgkmcnt(0)" ::: "memory")
__device__ __forceinline__ float wave_sum(float v) {
#pragma unroll
    for (int o = 1; o < 64; o <<= 1) v += __shfl_xor(v, o);
    return v;
}
__device__ __forceinline__ float wave_max(float v) {
#pragma unroll
    for (int o = 1; o < 64; o <<= 1) v = fmaxf(v, __shfl_xor(v, o));
    return v;
}
__device__ __forceinline__ float bf2f(unsigned b) { return __uint_as_float(b << 16); }
__device__ __forceinline__ unsigned f2bf(float f) { unsigned u = __float_as_uint(f); return (u + 0x7fffu + ((u >> 16) & 1u)) >> 16; }
__device__ __forceinline__ unsigned pk2(float lo, float hi) { return pg8::cvt_pk_bf16(lo, hi); }
__device__ __forceinline__ void unpack8(const u32x4 w, float (&v)[8]) {
    v[0] = bf2f(w.x & 0xffffu); v[1] = __uint_as_float(w.x & 0xffff0000u); v[2] = bf2f(w.y & 0xffffu); v[3] = __uint_as_float(w.y & 0xffff0000u);
    v[4] = bf2f(w.z & 0xffffu); v[5] = __uint_as_float(w.z & 0xffff0000u); v[6] = bf2f(w.w & 0xffffu); v[7] = __uint_as_float(w.w & 0xffff0000u);
}
__device__ __forceinline__ u32x4 pack8f(const float (&v)[8]) { u32x4 w; w.x = pk2(v[0], v[1]); w.y = pk2(v[2], v[3]); w.z = pk2(v[4], v[5]); w.w = pk2(v[6], v[7]); return w; }

struct Args { const float* in[23]; float* out; unsigned char* ws; };
enum { I_XP = 0, I_XS, I_CK, I_CV, I_CLF, I_CCONV, I_CP, I_CS, I_WADA, I_BADA, I_G1, I_G2, I_WIN, I_BF, I_WCONV, I_GATT, I_GCONV, I_WOUT, I_WUP, I_WDN, I_WADAF, I_BADAF, I_GF };

constexpr int NWAVES = 8, NTHR = 512;
constexpr int RING_BYTES = 131072, LDS_BYTES = 147456;

__device__ __forceinline__ void gemv24_group(const LAS float* A, LAS float* red, const float* W, int pitch, int col0, const float* bias, float* out, int opitch, int tid) {
    const int c = tid & 31, kg = tid >> 5;
    float acc[24];
#pragma unroll
    for (int r = 0; r < 24; ++r) acc[r] = 0.f;
    const float* wp = W + (size_t)(kg * 64) * pitch + col0 + c;
    const LAS float* ap = A + kg * 64;
#pragma unroll 2
    for (int k4 = 0; k4 < 16; ++k4) {
        const float w0 = wp[0], w1 = wp[pitch], w2 = wp[2 * (size_t)pitch], w3 = wp[3 * (size_t)pitch]; wp += 4 * (size_t)pitch;
#pragma unroll
        for (int r = 0; r < 24; ++r) { const f32x4 a = *(const LAS f32x4*)(ap + r * 1024 + k4 * 4); acc[r] += (a[0] * w0 + a[1] * w1) + (a[2] * w2 + a[3] * w3); }
    }
#pragma unroll
    for (int r = 0; r < 24; ++r) acc[r] += __shfl_xor(acc[r], 32);
    const int wid = tid >> 6, lane = tid & 63;
    if (lane < 32) {
#pragma unroll
        for (int r = 0; r < 24; ++r) red[(wid * 24 + r) * 32 + c] = acc[r];
    }
    __syncthreads();
    for (int o = tid; o < 768; o += NTHR) {
        const int r = o >> 5, cc = o & 31; float s = 0.f;
#pragma unroll
        for (int w = 0; w < 8; ++w) s += red[(w * 24 + r) * 32 + cc];
        if (bias) s += bias[col0 + cc];
        out[(size_t)r * opitch + col0 + cc] = s;
    }
    __syncthreads();
}

__device__ __forceinline__ void transpose_item(const float* W, int pitch, int K, bf16* WT, int k0, int nsrc0, int ndst0, LAS float* scr, int lane) {
#pragma unroll 8
    for (int i = 0; i < 32; ++i) { const int kk = 2 * i + (lane >> 5); scr[kk * 33 + (lane & 31)] = W[(size_t)(k0 + kk) * pitch + nsrc0 + (lane & 31)]; }
    LDS_WAIT(); asm volatile("" ::: "memory");
    const int c = lane & 7;
#pragma unroll
    for (int j = 0; j < 4; ++j) { const int n = (lane >> 3) + 8 * j; const LAS float* s = scr + (8 * c) * 33 + n;
        u32x4 o; o.x = pk2(s[0 * 33], s[1 * 33]); o.y = pk2(s[2 * 33], s[3 * 33]); o.z = pk2(s[4 * 33], s[5 * 33]); o.w = pk2(s[6 * 33], s[7 * 33]);
        *(u32x4*)(WT + (size_t)(ndst0 + n) * K + k0 + 8 * c) = o; }
    LDS_WAIT(); asm volatile("" ::: "memory");
}

namespace att {
constexpr int SEQ = 4096, D = 64, DM = 512, QB = 256, QBLK = 32, KVBLK = 64, NW = 8;
constexpr int SLOTB = 8192;
constexpr int LDS_K = 0, LDS_V = 2 * SLOTB, LDS_WS = 4 * SLOTB, LDS_OST = LDS_WS + 2048, LDS_F = LDS_OST + NW * 4096, LDS_END = LDS_F + 16384;
static_assert(LDS_END <= RING_BYTES, "attention LDS");
__device__ __forceinline__ int crow(int r, int hi) { return (r & 3) + 8 * (r >> 2) + 4 * hi; }
__device__ __forceinline__ void cmask(f32x16& p0, f32x16& p1, int jb, int qrel, int hi) {
    const float NEG = -INFINITY; const int kb = 64 * jb + 4 * hi;
#pragma unroll
    for (int r = 0; r < 16; ++r) { const int kv = kb + (r & 3) + 8 * (r >> 2); if (kv > qrel) p0[r] = NEG; if (kv + 32 > qrel) p1[r] = NEG; }
}
__device__ __forceinline__ void glds16(const void* gsrc, unsigned lds_dst) { unsigned keep;
    asm volatile("s_mov_b32 %0, m0\n\ts_mov_b32 m0, %2\n\ts_nop 0\n\tglobal_load_lds_dwordx4 %1, off\n\ts_mov_b32 m0, %0" : "=&s"(keep) : "v"(gsrc), "s"(lds_dst) : "memory"); }
__device__ __forceinline__ float max3f(float a, float b, float c) { return fmaxf(fmaxf(a, b), c); }
__device__ __forceinline__ float rowmax(const f32x16& p0, const f32x16& p1) {
    float a = max3f(p0[0], p0[1], p1[0]), b = max3f(p0[2], p0[3], p1[1]); a = max3f(a, p1[2], p1[3]);
#pragma unroll
    for (int r = 4; r < 16; r += 4) { a = max3f(a, p0[r], p0[r + 1]); b = max3f(b, p0[r + 2], p0[r + 3]); a = max3f(a, p1[r], p1[r + 1]); b = max3f(b, p1[r + 2], p1[r + 3]); }
    const float m = fmaxf(a, b);
    auto rr = __builtin_amdgcn_permlane32_swap(__float_as_uint(m), __float_as_uint(m), false, false);
    return fmaxf(__uint_as_float(rr[0]), __uint_as_float(rr[1]));
}
#define ATT_WAIT_BAR0() asm volatile("s_waitcnt vmcnt(0) lgkmcnt(0)\n\ts_barrier" ::: "memory")
__device__ __forceinline__ void qkt(f32x16& p0, f32x16& p1, const LAS char* Kslot, const bf16x8* qr, const f32x16& cin, int r32, int hi) {
    const LAS char* kb = Kslot + hi * 1024 + r32 * 16;
#pragma unroll
    for (int d0 = 0; d0 < 4; ++d0) {
        const bf16x8 b0 = *(const LAS bf16x8*)(kb + d0 * 2048);
        const bf16x8 b1 = *(const LAS bf16x8*)(kb + d0 * 2048 + 512);
        if (d0 == 0) { p0 = __builtin_amdgcn_mfma_f32_32x32x16_bf16(b0, qr[0], cin, 0, 0, 0); p1 = __builtin_amdgcn_mfma_f32_32x32x16_bf16(b1, qr[0], cin, 0, 0, 0); }
        else { p0 = __builtin_amdgcn_mfma_f32_32x32x16_bf16(b0, qr[d0], p0, 0, 0, 0); p1 = __builtin_amdgcn_mfma_f32_32x32x16_bf16(b1, qr[d0], p1, 0, 0, 0); }
    }
}
__device__ __forceinline__ void pv(f32x16* o, int vb, bf16x8 pa0, bf16x8 pa1, bf16x8 pa2, bf16x8 pa3) {
    s16x4 lo[2][4], hi[2][4];
#pragma unroll
    for (int d0 = 0; d0 < 2; ++d0)
#pragma unroll
        for (int ks = 0; ks < 4; ++ks) {
            asm volatile("ds_read_b64_tr_b16 %0,%1 offset:%c2" : "=&v"(lo[d0][ks]) : "v"(vb), "i"(d0 * 4096 + ks * 1024) : "memory");
            asm volatile("ds_read_b64_tr_b16 %0,%1 offset:%c2" : "=&v"(hi[d0][ks]) : "v"(vb), "i"(d0 * 4096 + ks * 1024 + 512) : "memory"); }
    asm volatile("s_waitcnt lgkmcnt(0)" ::: "memory"); __builtin_amdgcn_sched_barrier(0);
#define ATT_PK(d, k) (bf16x8){lo[d][k][0], lo[d][k][1], lo[d][k][2], lo[d][k][3], hi[d][k][0], hi[d][k][1], hi[d][k][2], hi[d][k][3]}
    o[0] = __builtin_amdgcn_mfma_f32_32x32x16_bf16(pa0, ATT_PK(0, 0), o[0], 0, 0, 0);
    o[1] = __builtin_amdgcn_mfma_f32_32x32x16_bf16(pa0, ATT_PK(1, 0), o[1], 0, 0, 0);
    o[0] = __builtin_amdgcn_mfma_f32_32x32x16_bf16(pa1, ATT_PK(0, 1), o[0], 0, 0, 0);
    o[1] = __builtin_amdgcn_mfma_f32_32x32x16_bf16(pa1, ATT_PK(1, 1), o[1], 0, 0, 0);
    o[0] = __builtin_amdgcn_mfma_f32_32x32x16_bf16(pa2, ATT_PK(0, 2), o[0], 0, 0, 0);
    o[1] = __builtin_amdgcn_mfma_f32_32x32x16_bf16(pa2, ATT_PK(1, 2), o[1], 0, 0, 0);
    o[0] = __builtin_amdgcn_mfma_f32_32x32x16_bf16(pa3, ATT_PK(0, 3), o[0], 0, 0, 0);
    o[1] = __builtin_amdgcn_mfma_f32_32x32x16_bf16(pa3, ATT_PK(1, 3), o[1], 0, 0, 0);
#undef ATT_PK
}
__device__ __forceinline__ void attn_unit(int b, int h, int qb, const bf16* Q, const bf16* __restrict__ K, const bf16* __restrict__ V, bf16* O, const float* __restrict__ F2g, LAS char* shm) {
    int tid_ = threadIdx.x; asm volatile("" : "+v"(tid_));
    const int tid = tid_, lane = tid & 63, r32 = lane & 31, hi = lane >> 5; const int wid = __builtin_amdgcn_readfirstlane(tid >> 6);
    const long rowbase = (long)b * SEQ; const int q0 = qb * QB;
    const bf16* Qw = Q + (rowbase + q0 + wid * QBLK) * DM + h * D;
    const bf16* Kh = K + rowbase * DM + h * D, *Vh = V + rowbase * DM + h * D;
    const unsigned lds0 = (unsigned)(uintptr_t)shm;
    LAS float* wsf = (LAS float*)(shm + LDS_WS) + wid * 64;
    LAS float* Fl = (LAS float*)(shm + LDS_F);
    const bf16* ksrc = Kh + (long)lane * DM + wid * 8;
    const bf16* vsrc = Vh + (long)(16 * (wid & 3) + (lane >> 2)) * DM + (wid >> 2) * 32 + (lane & 3) * 8;
    const unsigned kdst = lds0 + LDS_K + wid * 1024, vdst = lds0 + LDS_V + wid * 1024;
#define DMA_K(t, slot) glds16(ksrc + (long)(t) * KVBLK * DM, (unsigned)__builtin_amdgcn_readfirstlane(kdst + (slot)))
#define DMA_V(t, slot) glds16(vsrc + (long)(t) * KVBLK * DM, (unsigned)__builtin_amdgcn_readfirstlane(vdst + (slot)))
    const int vb0 = (int)(lds0 + LDS_V) + ((lane >> 4) & 1) * 32 + (lane & 3) * 8 + (4 * hi + ((lane & 15) >> 2)) * 64;
    const int NT = (q0 + QB) / KVBLK;
    DMA_K(0, 0); DMA_V(0, 0);
    for (int i = tid; i < NT * 64; i += NTHR) Fl[i] = F2g[i];
    bf16x8 qr[4];
#pragma unroll
    for (int d0 = 0; d0 < 4; ++d0) qr[d0] = *reinterpret_cast<const bf16x8*>(&Qw[(long)r32 * DM + d0 * 16 + hi * 8]);
    const float fqv = F2g[q0 + wid * QBLK + r32];
    f32x16 cin;
#pragma unroll
    for (int r = 0; r < 16; ++r) cin[r] = fqv;
    float mref = 0.f, l_reg = 0.f; f32x16 o[2];
#pragma unroll
    for (int r = 0; r < 16; ++r) { o[0][r] = 0.f; o[1][r] = 0.f; }
    const int qrel = wid * QBLK + r32;
    for (int t = 0; t < NT; ++t) {
        const int slot = (t & 1) * SLOTB;
        ATT_WAIT_BAR0();
        if (t + 1 < NT) { DMA_K(t + 1, slot ^ SLOTB); DMA_V(t + 1, slot ^ SLOTB); }
        const int jb = t - (NT - 4);
        if (jb >= 0 && 64 * jb > wid * QBLK + 31) continue;
        f32x16 p0, p1;
        qkt(p0, p1, (const LAS char*)(shm + LDS_K + slot), qr, cin, r32, hi);
#pragma unroll
        for (int g = 0; g < 4; ++g) {
            const f32x4 f0 = *(const LAS f32x4*)(Fl + 64 * t + 8 * g + 4 * hi), f1 = *(const LAS f32x4*)(Fl + 64 * t + 32 + 8 * g + 4 * hi);
#pragma unroll
            for (int j = 0; j < 4; ++j) { p0[4 * g + j] -= f0[j]; p1[4 * g + j] -= f1[j]; }
        }
        if (jb >= 0) cmask(p0, p1, jb, qrel, hi);
        const float rm = rowmax(p0, p1);
        bool resc = false;
        if (t == 0 || __any(rm > 8.0f)) {
            const float dl = (t == 0) ? rm : fmaxf(rm, 0.f);
            mref += dl;
#pragma unroll
            for (int r = 0; r < 16; ++r) { p0[r] -= dl; p1[r] -= dl; }
#pragma unroll
            for (int r = 0; r < 16; ++r) cin[r] = fqv - mref;
            if (t != 0) { const float f = __builtin_amdgcn_exp2f(-dl); l_reg *= f; if (hi == 0) wsf[r32] = f; resc = true; }
        }
        float sacc = 0.f;
#pragma unroll
        for (int r = 0; r < 16; ++r) { p0[r] = __builtin_amdgcn_exp2f(p0[r]); p1[r] = __builtin_amdgcn_exp2f(p1[r]); sacc += p0[r] + p1[r]; }
        l_reg += sacc;
        u32x4 pw0, pw1, pw2, pw3;
        pw0 = (u32x4){pk2(p0[0], p0[1]), pk2(p0[2], p0[3]), pk2(p0[4], p0[5]), pk2(p0[6], p0[7])};
        pw1 = (u32x4){pk2(p0[8], p0[9]), pk2(p0[10], p0[11]), pk2(p0[12], p0[13]), pk2(p0[14], p0[15])};
        pw2 = (u32x4){pk2(p1[0], p1[1]), pk2(p1[2], p1[3]), pk2(p1[4], p1[5]), pk2(p1[6], p1[7])};
        pw3 = (u32x4){pk2(p1[8], p1[9]), pk2(p1[10], p1[11]), pk2(p1[12], p1[13]), pk2(p1[14], p1[15])};
        if (resc) {
            LDS_WAIT();
#pragma unroll
            for (int r = 0; r < 16; ++r) { const float f = wsf[crow(r, hi)]; o[0][r] *= f; o[1][r] *= f; }
        }
        pv(o, vb0 + slot, __builtin_bit_cast(bf16x8, pw0), __builtin_bit_cast(bf16x8, pw1), __builtin_bit_cast(bf16x8, pw2), __builtin_bit_cast(bf16x8, pw3));
    }
    { auto rr = __builtin_amdgcn_permlane32_swap(__float_as_uint(l_reg), __float_as_uint(l_reg), false, false); l_reg = __uint_as_float(rr[0]) + __uint_as_float(rr[1]); }
    if (hi == 0) wsf[32 + r32] = l_reg; LDS_WAIT();
    float rli[16];
#pragma unroll
    for (int r = 0; r < 16; ++r) rli[r] = __builtin_amdgcn_rcpf(wsf[32 + crow(r, hi)]);
    bf16* Ow = O + (rowbase + q0 + wid * QBLK) * DM + h * D;
    { LAS bf16* stg = (LAS bf16*)(shm + LDS_OST) + wid * 2048;
#pragma unroll
      for (int r = 0; r < 16; ++r) { const int orow = crow(r, hi);
#pragma unroll
        for (int d0 = 0; d0 < 2; ++d0) stg[orow * 64 + d0 * 32 + r32] = (bf16)f2bf(o[d0][r] * rli[r]); }
      LDS_WAIT();
#pragma unroll
      for (int i = 0; i < 4; ++i) { const int row = i * 8 + (lane >> 3), ch = lane & 7; const u32x4 v = *(const LAS u32x4*)(stg + row * 64 + ch * 8); *(u32x4*)(Ow + (long)row * DM + ch * 8) = v; } }
    asm volatile("s_waitcnt vmcnt(0) lgkmcnt(0)\n\ts_barrier" ::: "memory");
#undef DMA_K
#undef DMA_V
}
}

__device__ __forceinline__ void attn_sample_unit(int b, int h, int sp, const Args& a, LAS char* shm) {
    const int tid = threadIdx.x, lane = tid & 63; const int wid = __builtin_amdgcn_readfirstlane(tid >> 6);
    LAS float* qs = (LAS float*)shm;
    LAS float* ps = (LAS float*)(shm + 4096) + wid * 1024;
    LAS float* red = (LAS float*)(shm + 4096 + 32768);
    const bf16* Qb = (const bf16*)(a.ws + R1_Q) + (size_t)(MP + 16 * b) * 512 + h * 64;
    for (int i = tid; i < 1024; i += NTHR) qs[i] = bf2f(Qb[(i >> 6) * 512 + (i & 63)]);
    const float* F = (const float*)(a.ws + WS_FSS) + (size_t)(b * 8 + h) * 4112;
    __syncthreads();
    float m[16], ll[16], o[16];
#pragma unroll
    for (int i = 0; i < 16; ++i) { m[i] = -1e30f; ll[i] = 0.f; o[i] = 0.f; }
    const int nch = (sp == 3 && wid == 0) ? 3 : 2;
    for (int ch = 0; ch < nch; ++ch) {
        int key0, nvalid; const float* kbase; const float* vbase;
        if (ch < 2) { key0 = 1024 * sp + 128 * wid + 64 * ch; nvalid = 64; const size_t off = ((size_t)(b * 4096 + key0) * 8 + h) * 64; kbase = a.in[I_CK] + off; vbase = a.in[I_CV] + off; }
        else { key0 = 4096; nvalid = 16; const size_t off = ((size_t)(b * 16) * 8 + h) * 64; kbase = a.out + O_KS + off; vbase = a.out + O_VS + off; }
        const bool valid = lane < nvalid; const int key = key0 + lane;
        const float* kp = kbase + (size_t)(valid ? lane : 0) * 512;
        float s[16];
#pragma unroll
        for (int i = 0; i < 16; ++i) s[i] = 0.f;
#pragma unroll 4
        for (int d4 = 0; d4 < 16; ++d4) {
            const f32x4 kk = *(const f32x4*)(kp + 4 * d4);
#pragma unroll
            for (int i = 0; i < 16; ++i) { const f32x4 q4 = *(const LAS f32x4*)(qs + i * 64 + 4 * d4); s[i] += (q4[0] * kk[0] + q4[1] * kk[1]) + (q4[2] * kk[2] + q4[3] * kk[3]); }
        }
        const float fk = F[valid ? key : 0];
#pragma unroll
        for (int i = 0; i < 16; ++i) {
            float sv = s[i] + (F[4096 + i] - fk);
            if (!valid || key > 4096 + i) sv = -INFINITY;
            const float cm = wave_max(sv), mn = fmaxf(m[i], cm), al = __builtin_amdgcn_exp2f(m[i] - mn), p = __builtin_amdgcn_exp2f(sv - mn);
            ll[i] = ll[i] * al + p; o[i] *= al; m[i] = mn; s[i] = p;
        }
#pragma unroll
        for (int i4 = 0; i4 < 4; ++i4) *(LAS f32x4*)(ps + lane * 16 + 4 * i4) = (f32x4){s[4 * i4], s[4 * i4 + 1], s[4 * i4 + 2], s[4 * i4 + 3]};
        LDS_WAIT();
#pragma unroll 8
        for (int k = 0; k < nvalid; ++k) {
            const float v = vbase[(size_t)k * 512 + lane];
#pragma unroll
            for (int i4 = 0; i4 < 4; ++i4) { const f32x4 p4 = *(const LAS f32x4*)(ps + k * 16 + 4 * i4);
                o[4 * i4] += p4[0] * v; o[4 * i4 + 1] += p4[1] * v; o[4 * i4 + 2] += p4[2] * v; o[4 * i4 + 3] += p4[3] * v; }
        }
        LDS_WAIT();
    }
#pragma unroll
    for (int i = 0; i < 16; ++i) ll[i] = wave_sum(ll[i]);
#pragma unroll
    for (int i = 0; i < 16; ++i) red[(wid * 16 + i) * 66 + lane] = o[i];
    if (lane == 0) {
#pragma unroll
        for (int i = 0; i < 16; ++i) { red[(wid * 16 + i) * 66 + 64] = m[i]; red[(wid * 16 + i) * 66 + 65] = ll[i]; }
    }
    __syncthreads();
    {
        const int i = tid >> 5, dd = tid & 31;
        float M = -1e30f;
#pragma unroll
        for (int w = 0; w < 8; ++w) M = fmaxf(M, red[(w * 16 + i) * 66 + 64]);
        float L = 0.f, O0 = 0.f, O1 = 0.f;
#pragma unroll
        for (int w = 0; w < 8; ++w) { const float f = __builtin_amdgcn_exp2f(red[(w * 16 + i) * 66 + 64] - M); L += red[(w * 16 + i) * 66 + 65] * f; O0 += red[(w * 16 + i) * 66 + dd] * f; O1 += red[(w * 16 + i) * 66 + dd + 32] * f; }
        float* pp = (float*)(a.ws + WS_PART) + ((size_t)((b * 8 + h) * 4 + sp) * 16 + i) * 66;
        pp[dd] = O0; pp[dd + 32] = O1; if (dd == 0) { pp[64] = M; pp[65] = L; }
    }
    __syncthreads();
}

__device__ __forceinline__ void scan_seq(int seq, const Args& a, LAS float* sm) {
    const int tid = threadIdx.x, lane = tid & 63, wid = tid >> 6;
    const bool smp = seq >= 128; const int s = smp ? seq - 128 : seq; const int b = s >> 3, h = s & 7;
    const float* src = smp ? a.in[I_CLF] + (size_t)(b * 4096) * 8 + h : a.out + O_LP + (size_t)(b * 4096) * 8 + h;
    float v[8]; float run = 0.f;
#pragma unroll
    for (int i = 0; i < 8; ++i) { run += src[(size_t)(tid * 8 + i) * 8]; v[i] = run; }
    float inc = run;
#pragma unroll
    for (int o = 1; o < 64; o <<= 1) { const float t = __shfl_up(inc, o); if (lane >= o) inc += t; }
    if (lane == 63) sm[wid] = inc;
    __syncthreads();
    float off = inc - run;
    for (int w = 0; w < wid; ++w) off += sm[w];
    float* dst = smp ? (float*)(a.ws + WS_FSS) + (size_t)s * 4112 : (float*)(a.ws + WS_FS) + (size_t)s * 4096;
#pragma unroll
    for (int i = 0; i < 8; ++i) dst[tid * 8 + i] = (off + v[i]) * LOG2E;
    if (smp && tid == NTHR - 1) {
        float r2 = off + v[7];
        for (int i = 0; i < 16; ++i) { r2 += a.out[O_LS + (size_t)(b * 16 + i) * 8 + h]; dst[4096 + i] = r2 * LOG2E; }
    }
    __syncthreads();
}

__device__ __forceinline__ f32x4 thin_gemm(const bf16* A, int lda, const bf16* Bt, int ldb, int kbeg, int klen, int n0, int wave, int lane) {
    const int fr = lane & 15, fq = lane >> 4;
    const bf16* ap = A + (size_t)(16 * wave + fr) * lda + kbeg + 8 * fq;
    const bf16* bp = Bt + (size_t)(n0 + fr) * ldb + kbeg + 8 * fq;
    f32x4 acc0 = {0.f, 0.f, 0.f, 0.f}, acc1 = {0.f, 0.f, 0.f, 0.f};
#pragma unroll 4
    for (int k = 0; k < klen; k += 64) {
        const bf16x8 a0 = *(const bf16x8*)(ap + k), b0 = *(const bf16x8*)(bp + k), a1 = *(const bf16x8*)(ap + k + 32), b1 = *(const bf16x8*)(bp + k + 32);
        acc0 = __builtin_amdgcn_mfma_f32_16x16x32_bf16(b0, a0, acc0, 0, 0, 0);
        acc1 = __builtin_amdgcn_mfma_f32_16x16x32_bf16(b1, a1, acc1, 0, 0, 0);
    }
    return acc0 + acc1;
}

#ifndef REP_GEMM
#define REP_GEMM 1
#endif
__global__ void __launch_bounds__(NTHR, 2) hymba_fwd(Args a) {
    extern __shared__ __attribute__((aligned(16))) unsigned char lds_raw[];
    LAS unsigned char* lds = (LAS unsigned char*)lds_raw;
    cg::grid_group grid = cg::this_grid();
    const int tid = threadIdx.x, lane = tid & 63; const int wave = __builtin_amdgcn_readfirstlane(tid >> 6);
    const int G = gridDim.x, bx = blockIdx.x;
    const int vcu = (G % 8 == 0) ? (bx % 8) * (G / 8) + bx / 8 : bx;
    const int gw = vcu * NWAVES + wave, NGW = G * NWAVES;
    unsigned char* ws = a.ws;
    float* mod = (float*)(ws + WS_MOD); float* modf = (float*)(ws + WS_MODF); float* gm2 = (float*)(ws + WS_GM2); float* BU = (float*)(ws + WS_BU);
    bf16* Win_t = (bf16*)(ws + WS_WIN); bf16* Wout_t = (bf16*)(ws + WS_WOUT); bf16* Wup_t = (bf16*)(ws + WS_WUP); bf16* Wdn_t = (bf16*)(ws + WS_WDN);
    bf16* XN = (bf16*)(ws + R1_XN); bf16* QB = (bf16*)(ws + R1_Q); bf16* Hb = (bf16*)(ws + WS_R1);
    float* SST = (float*)(ws + WS_SST);
    float* X1 = (float*)(ws + WS_X1); bf16* A2 = (bf16*)(ws + WS_A2); float* SS = (float*)(ws + WS_SS);

    {
        LAS float* A = (LAS float*)lds; LAS float* red = (LAS float*)(lds + 98304);
        for (int i = tid; i < 24 * 1024; i += NTHR) { const int r = i >> 10, k = i & 1023; const float c = (r < 16) ? a.in[I_CP][r * 1024 + k] : a.in[I_CS][(r - 16) * 1024 + k]; A[i] = c / (1.f + __expf(-c)); }
        __syncthreads();
        for (int grp = bx; grp < 256; grp += G) {
            const int col = grp * 32;
            if (col < 6144) gemv24_group(A, red, a.in[I_WADA], 6144, col, a.in[I_BADA], mod, 6144, tid);
            else gemv24_group(A, red, a.in[I_WADAF], 2048, col - 6144, a.in[I_BADAF], modf, 2048, tid);
        }
        __syncthreads();
    }
    {
        LAS float* scr = (LAS float*)(lds + wave * 16384);
        constexpr int I_IN = 16 * 96, I_OUT = 16 * 32, I_UP = 16 * 128, I_DN = 64 * 32, NITEMS = I_IN + I_OUT + I_UP + I_DN;
        for (int it = gw; it < NITEMS; it += NGW) {
            int r = it;
            if (r < I_IN) { const int kb = r / 96, nb = r % 96; transpose_item(a.in[I_WIN], PROJ, 1024, Win_t, 64 * kb, 32 * nb + (nb >= 48 ? 8 : 0), 32 * nb, scr, lane); continue; } r -= I_IN;
            if (r < I_OUT) { const int kb = r / 32, nb = r % 32; transpose_item(a.in[I_WOUT], 1024, 1024, Wout_t, 64 * kb, 32 * nb, 32 * nb, scr, lane); continue; } r -= I_OUT;
            if (r < I_UP) { const int kb = r / 128, nb = r % 128; transpose_item(a.in[I_WUP], 4096, 1024, Wup_t, 64 * kb, 32 * nb, 32 * nb, scr, lane); continue; } r -= I_UP;
            { const int kb = r / 32, nb = r % 32; transpose_item(a.in[I_WDN], 1024, 4096, Wdn_t, 64 * kb, 32 * nb, 32 * nb, scr, lane); }
        }
    }
    grid.sync();
    {
        LAS float* WfT = (LAS float*)lds;
        for (int i = tid; i < 8192; i += NTHR) { const int hh = i & 7, k = i >> 3; WfT[hh * 1024 + k] = a.in[I_WIN][(size_t)k * PROJ + 1536 + hh]; }
        for (int i = bx * NTHR + tid; i < 24 * 1024; i += G * NTHR) { const int r = i >> 10, k = i & 1023; gm2[i] = a.in[I_G2][k] * (1.f + mod[(size_t)r * 6144 + 4096 + k]); }
        __syncthreads();
        f32x4 g1v[4];
#pragma unroll
        for (int j = 0; j < 4; ++j) g1v[j] = ((const f32x4*)a.in[I_G1])[lane + 64 * j];
        for (int row = gw; row < MPAD; row += NGW) {
            u32x2* xo = (u32x2*)(XN + (size_t)row * 1024) + lane;
            if (row >= MP + MS) {
#pragma unroll
                for (int j = 0; j < 4; ++j) xo[64 * j] = (u32x2){0u, 0u};
                continue;
            }
            const float* xr = (row < MP) ? a.in[I_XP] + (size_t)row * 1024 : a.in[I_XS] + (size_t)(row - MP) * 1024;
            const int mr = (row < MP) ? (row >> 12) : 16 + ((row - MP) >> 4);
            const f32x4* x4 = (const f32x4*)xr + lane; const f32x4* sh4 = (const f32x4*)(mod + (size_t)mr * 6144) + lane; const f32x4* sc4 = (const f32x4*)(mod + (size_t)mr * 6144 + 1024) + lane;
            f32x4 v[4]; float ss = 0.f;
#pragma unroll
            for (int j = 0; j < 4; ++j) { v[j] = x4[64 * j]; ss += (v[j][0] * v[j][0] + v[j][1] * v[j][1]) + (v[j][2] * v[j][2] + v[j][3] * v[j][3]); }
            const float rstd = 1.0f / sqrtf(wave_sum(ss) * (1.0f / 1024.0f) + NORM_EPS);
            float fl[8];
#pragma unroll
            for (int hh = 0; hh < 8; ++hh) fl[hh] = 0.f;
#pragma unroll
            for (int j = 0; j < 4; ++j) {
                const f32x4 hv = (v[j] * rstd) * g1v[j] * (sc4[64 * j] + 1.0f) + sh4[64 * j];
                xo[64 * j] = (u32x2){pk2(hv[0], hv[1]), pk2(hv[2], hv[3])};
#pragma unroll
                for (int hh = 0; hh < 8; ++hh) { const f32x4 w = *(const LAS f32x4*)(WfT + hh * 1024 + 4 * lane + 256 * j); fl[hh] += (hv[0] * w[0] + hv[1] * w[1]) + (hv[2] * w[2] + hv[3] * w[3]); }
            }
            float z = 0.f;
#pragma unroll
            for (int hh = 0; hh < 8; ++hh) { const float t = wave_sum(fl[hh]); z = (lane == hh) ? t : z; }
            if (lane < 8) {
                z += a.in[I_BF][lane];
                const float lf = fminf(z, 0.f) - log1pf(__expf(-fabsf(z)));
                if (row < MP) a.out[O_LP + (size_t)row * 8 + lane] = lf; else a.out[O_LS + (size_t)(row - MP) * 8 + lane] = lf;
            }
        }
    }
    grid.sync();
    {
        for (int seq = bx; seq < 192; seq += G) scan_seq(seq, a, (LAS float*)lds);
        __syncthreads();
        for (int slab = vcu; slab < NIN / 16; slab += G) {
            const int n0 = slab * 16, fr = lane & 15, fq = lane >> 4;
            const f32x4 acc = thin_gemm(XN + (size_t)MP * 1024, 1024, Win_t, 1024, 0, 1024, n0, wave, lane);
            const int c = n0 + 4 * fq, t = c >> 9, cc = c & 511, row = 16 * wave + fr;
            const f32x4 v = acc * ((t == 0) ? QSCALE : 1.f);
            *(u32x2*)(QB + (size_t)t * BUF512 + (size_t)(MP + row) * 512 + cc) = (u32x2){pk2(v[0], v[1]), pk2(v[2], v[3])};
            if (t == 1) *(f32x4*)(a.out + O_KS + (size_t)row * 512 + cc) = v;
            if (t == 2) *(f32x4*)(a.out + O_VS + (size_t)row * 512 + cc) = v;
        }
        pg8::Gemm g{XN, Win_t, MP, NIN, 1024}; pg8::StaticOrder S; S.init(MP, NIN, G, bx);
        pg8::EpiIn E{QB, a.out};
        for (int rep_ = 0; rep_ < REP_GEMM; ++rep_) pg8::gemm_phase<pg8::EpiIn, pg8::StaticOrder, true, true>(lds, g, S, E);
    }
    grid.sync();
    {
        const bf16* Qp = QB; const bf16* Kp = QB + BUF512; const bf16* Vp = QB + 2 * BUF512;
        for (int u = vcu; u < 256; u += G) attn_sample_unit(u >> 5, (u >> 2) & 7, u & 3, a, (LAS char*)lds);
#ifndef REP_ATT
#define REP_ATT 1
#endif
        for (int rep_ = 0; rep_ < REP_ATT; ++rep_)
        for (int u = vcu; u < 2048; u += G) {
            const int c = u & 255, i = u >> 8; const int bh = c >> 1, par = c & 1;
            const int k = 7 - i;
            const int qb = par ? ((k & 1) ? 4 * (k >> 1) + 2 : 4 * (k >> 1) + 1) : ((k & 1) ? 4 * (k >> 1) + 3 : 4 * (k >> 1));
            att::attn_unit(bh >> 3, bh & 7, qb, Qp, Kp, Vp, A2, (const float*)(ws + WS_FS) + (size_t)bh * 4096, (LAS char*)lds);
        }
    }
    grid.sync();
    {
        {
            LAS float* A = (LAS float*)lds; LAS float* red = (LAS float*)(lds + 98304);
            if (bx < 128) {
                for (int i = tid; i < 24 * 1024; i += NTHR) { const int r = i >> 10, k = i & 1023; A[i] = mod[(size_t)r * 6144 + 3072 + k]; }
                __syncthreads();
                for (int grp = bx; grp < 128; grp += G) gemv24_group(A, red, a.in[I_WUP], 4096, grp * 32, nullptr, BU, 4096, tid);
            }
        }
        const bf16* Ob = A2; const bf16* BGb = QB + 3 * BUF512; const bf16* CGb = QB + 4 * BUF512; const bf16* Ub = QB + 5 * BUF512;
        bf16* MG = XN;
        const int c0 = 8 * lane;
        float gatt[8], gconv[8], w0[8], w1[8], w2[8];
#pragma unroll
        for (int j = 0; j < 8; ++j) { gatt[j] = a.in[I_GATT][c0 + j]; gconv[j] = a.in[I_GCONV][c0 + j]; w0[j] = a.in[I_WCONV][c0 + j]; w1[j] = a.in[I_WCONV][512 + c0 + j]; w2[j] = a.in[I_WCONV][1024 + c0 + j]; }
        for (int run = gw; run < 2048 + 8; run += NGW) {
            const bool smp = run >= 2048; const int bs = run - 2048;
            const int row0 = smp ? MP + bs * 16 : run * 32; const int nrows = smp ? 16 : 32;
            float um2[8], um1[8];
            if (smp) {
#pragma unroll
                for (int j = 0; j < 8; ++j) { um2[j] = a.in[I_CCONV][(size_t)(bs * 2) * 512 + c0 + j]; um1[j] = a.in[I_CCONV][(size_t)(bs * 2 + 1) * 512 + c0 + j]; }
            } else if ((row0 & 4095) == 0) {
#pragma unroll
                for (int j = 0; j < 8; ++j) { um2[j] = 0.f; um1[j] = 0.f; }
            } else {
                float ca[8], ua[8];
                unpack8(*(const u32x4*)(CGb + (size_t)(row0 - 2) * 512 + c0), ca); unpack8(*(const u32x4*)(Ub + (size_t)(row0 - 2) * 512 + c0), ua);
#pragma unroll
                for (int j = 0; j < 8; ++j) um2[j] = ca[j] * ua[j];
                unpack8(*(const u32x4*)(CGb + (size_t)(row0 - 1) * 512 + c0), ca); unpack8(*(const u32x4*)(Ub + (size_t)(row0 - 1) * 512 + c0), ua);
#pragma unroll
                for (int j = 0; j < 8; ++j) um1[j] = ca[j] * ua[j];
            }
            for (int rr = 0; rr < nrows; ++rr) {
                const int row = row0 + rr;
                float at[8];
                if (!smp) unpack8(*(const u32x4*)(Ob + (size_t)row * 512 + c0), at);
                else {
                    const int hh = lane >> 3, d0 = (lane & 7) * 8;
                    const float* pp = (const float*)(ws + WS_PART) + ((size_t)((bs * 8 + hh) * 4) * 16 + rr) * 66;
                    float M = -1e30f;
#pragma unroll
                    for (int sp = 0; sp < 4; ++sp) M = fmaxf(M, pp[(size_t)sp * 16 * 66 + 64]);
                    float L = 0.f;
#pragma unroll
                    for (int j = 0; j < 8; ++j) at[j] = 0.f;
#pragma unroll
                    for (int sp = 0; sp < 4; ++sp) { const float* q = pp + (size_t)sp * 16 * 66; const float f = __builtin_amdgcn_exp2f(q[64] - M); L += q[65] * f;
#pragma unroll
                        for (int j = 0; j < 8; ++j) at[j] += q[d0 + j] * f; }
                    const float rl = 1.0f / L;
#pragma unroll
                    for (int j = 0; j < 8; ++j) at[j] *= rl;
                }
                float ss = 0.f;
#pragma unroll
                for (int j = 0; j < 8; ++j) ss += at[j] * at[j];
                const float ra = 1.0f / sqrtf(wave_sum(ss) * (1.0f / 512.0f) + NORM_EPS);
#pragma unroll
                for (int j = 0; j < 8; ++j) at[j] = at[j] * ra * gatt[j];
                *(u32x4*)(MG + (size_t)row * 1024 + c0) = pack8f(at);
                float bgv[8], ca[8], ua[8], u8[8], y[8];
                unpack8(*(const u32x4*)(BGb + (size_t)row * 512 + c0), bgv); unpack8(*(const u32x4*)(CGb + (size_t)row * 512 + c0), ca); unpack8(*(const u32x4*)(Ub + (size_t)row * 512 + c0), ua);
                float s2 = 0.f;
#pragma unroll
                for (int j = 0; j < 8; ++j) { u8[j] = ca[j] * ua[j]; y[j] = bgv[j] * (w0[j] * um2[j] + w1[j] * um1[j] + w2[j] * u8[j]); s2 += y[j] * y[j]; }
                const float rc = 1.0f / sqrtf(wave_sum(s2) * (1.0f / 512.0f) + NORM_EPS);
#pragma unroll
                for (int j = 0; j < 8; ++j) y[j] = y[j] * rc * gconv[j];
                *(u32x4*)(MG + (size_t)row * 1024 + 512 + c0) = pack8f(y);
                if (!smp) { const int t = row & 4095; if (t >= 4094) { float* co = a.out + O_CP + (size_t)((row >> 12) * 2 + (t - 4094)) * 512 + c0;
#pragma unroll
                        for (int j = 0; j < 8; ++j) co[j] = u8[j]; } }
                else if (rr >= 14) { float* co = a.out + O_CS + (size_t)(bs * 2 + (rr - 14)) * 512 + c0;
#pragma unroll
                        for (int j = 0; j < 8; ++j) co[j] = u8[j]; }
#pragma unroll
                for (int j = 0; j < 8; ++j) { um2[j] = um1[j]; um1[j] = u8[j]; }
            }
        }
    }
    grid.sync();
    {
        for (int slab = vcu; slab < 64; slab += G) {
            const int n0 = slab * 16, fr = lane & 15, fq = lane >> 4;
            const f32x4 acc = thin_gemm(XN + (size_t)MP * 1024, 1024, Wout_t, 1024, 0, 1024, n0, wave, lane);
            const int c = n0 + 4 * fq, row = 16 * wave + fr, mr = 16 + wave;
            const f32x4 xv = *(const f32x4*)(a.in[I_XS] + (size_t)row * 1024 + c), gt = *(const f32x4*)(mod + (size_t)mr * 6144 + 2048 + c), gm = *(const f32x4*)(gm2 + (size_t)mr * 1024 + c);
            const f32x4 r0 = xv + gt * acc;
            *(f32x4*)(X1 + (size_t)(MP + row) * 1024 + c) = r0;
            const f32x4 am = r0 * gm;
            *(u32x2*)(A2 + (size_t)(MP + row) * 1024 + c) = (u32x2){pk2(am[0], am[1]), pk2(am[2], am[3])};
            float s = (r0[0] * r0[0] + r0[1] * r0[1]) + (r0[2] * r0[2] + r0[3] * r0[3]);
            s += __shfl_xor(s, 16); s += __shfl_xor(s, 32);
            if (fq == 0) SST[row * 64 + slab] = s;
        }
        pg8::Gemm g{XN, Wout_t, MP, 1024, 1024}; pg8::StaticOrder S; S.init(MP, 1024, G, bx);
        pg8::EpiOut E{a.in[I_XP], mod, gm2, X1, A2, SS};
        for (int rep_ = 0; rep_ < REP_GEMM; ++rep_) pg8::gemm_phase<pg8::EpiOut, pg8::StaticOrder, true, true>(lds, g, S, E);
    }
    grid.sync();
    {
        for (int slab = vcu; slab < 256; slab += G) {
            const int n0 = slab * 16, fr = lane & 15, fq = lane >> 4;
            const int row = 16 * wave + fr, mr = 16 + wave;
            const f32x4* sp = (const f32x4*)(SST + row * 64 + 16 * fq);
            const f32x4 s4 = (sp[0] + sp[1]) + (sp[2] + sp[3]);
            float s = (s4[0] + s4[1]) + (s4[2] + s4[3]);
            s += __shfl_xor(s, 16); s += __shfl_xor(s, 32);
            const float rstd = 1.0f / sqrtf(s * (1.0f / 1024.0f) + NORM_EPS);
            const f32x4 acc = thin_gemm(A2 + (size_t)MP * 1024, 1024, Wup_t, 1024, 0, 1024, n0, wave, lane);
            const int c = n0 + 4 * fq;
            f32x4 v = acc * rstd + *(const f32x4*)(BU + (size_t)mr * 4096 + c);
#pragma unroll
            for (int j = 0; j < 4; ++j) { const float q = fmaxf(v[j], 0.f); v[j] = q * q; }
            *(u32x2*)(Hb + (size_t)(MP + row) * 4096 + c) = (u32x2){pk2(v[0], v[1]), pk2(v[2], v[3])};
        }
        pg8::Gemm g{A2, Wup_t, MP, FFD, 1024}; pg8::StaticOrder S; S.init(MP, FFD, G, bx);
        pg8::EpiUp E{SS, BU, Hb, (LAS float*)(lds + RING_BYTES)};
        for (int rep_ = 0; rep_ < REP_GEMM; ++rep_) pg8::gemm_phase<pg8::EpiUp, pg8::StaticOrder, true, true>(lds, g, S, E);
    }
    grid.sync();
    {
        for (int slab = vcu; slab < 256; slab += G) {
            const int n0 = (slab & 63) * 16, ks = slab >> 6, fr = lane & 15, fq = lane >> 4;
            const f32x4 acc = thin_gemm(Hb + (size_t)MP * 4096, 4096, Wdn_t, 4096, ks * 1024, 1024, n0, wave, lane);
            const int c = n0 + 4 * fq, row = 16 * wave + fr, mr = 16 + wave;
            const f32x4 gt = *(const f32x4*)(mod + (size_t)mr * 6144 + 5120 + c);
            float* xo = X1 + (size_t)(MP + row) * 1024 + c;
#pragma unroll
            for (int j = 0; j < 4; ++j) atomicAdd(xo + j, gt[j] * acc[j]);
        }
        pg8::Gemm g{Hb, Wdn_t, MP, 1024, FFD}; pg8::StaticOrder S; S.init(MP, 1024, G, bx);
        pg8::EpiDown E{mod, X1};
        pg8::gemm_phase<pg8::EpiDown, pg8::StaticOrder, true, true>(lds, g, S, E);
    }
    grid.sync();
    {
        f32x4 gfv[4];
#pragma unroll
        for (int j = 0; j < 4; ++j) gfv[j] = ((const f32x4*)a.in[I_GF])[lane + 64 * j];
        for (int row = gw; row < MP + MS; row += NGW) {
            const int mr = (row < MP) ? (row >> 12) : 16 + ((row - MP) >> 4);
            const f32x4* x4 = (const f32x4*)(X1 + (size_t)row * 1024) + lane;
            const f32x4* sh4 = (const f32x4*)(modf + (size_t)mr * 2048) + lane; const f32x4* sc4 = (const f32x4*)(modf + (size_t)mr * 2048 + 1024) + lane;
            f32x4* yo = (f32x4*)((row < MP) ? a.out + O_YP + (size_t)row * 1024 : a.out + O_YS + (size_t)(row - MP) * 1024) + lane;
            f32x4 v[4]; float ss = 0.f;
#pragma unroll
            for (int j = 0; j < 4; ++j) { v[j] = x4[64 * j]; ss += (v[j][0] * v[j][0] + v[j][1] * v[j][1]) + (v[j][2] * v[j][2] + v[j][3] * v[j][3]); }
            const float rstd = 1.0f / sqrtf(wave_sum(ss) * (1.0f / 1024.0f) + NORM_EPS);
#pragma unroll
            for (int j = 0; j < 4; ++j) yo[64 * j] = (v[j] * rstd) * gfv[j] * (sc4[64 * j] + 1.0f) + sh4[64 * j];
        }
    }
}

extern "C" void kernel_launch(void* const* d_in, const int* in_sizes, int n_in, void* d_out, int out_size, void* d_ws, size_t ws_size, hipStream_t stream) {
    static int grid = 0;
    if (grid == 0) {
        if (n_in != 23 || ws_size < WS_END) { fprintf(stderr, "kernel_launch: expected 23 inputs and >= %zu bytes of workspace; got %d, %zu\n", (size_t)WS_END, n_in, ws_size); grid = -1; return; }
        int dev = 0, cus = 0, per_cu = 0;
        hipGetDevice(&dev); hipDeviceGetAttribute(&cus, hipDeviceAttributeMultiprocessorCount, dev);
        hipFuncSetAttribute((const void*)hymba_fwd, hipFuncAttributeMaxDynamicSharedMemorySize, LDS_BYTES);
        hipOccupancyMaxActiveBlocksPerMultiprocessor(&per_cu, (const void*)hymba_fwd, NTHR, LDS_BYTES);
        if (per_cu < 1) { fprintf(stderr, "kernel_launch: occupancy query says %d blocks per CU\n", per_cu); per_cu = 1; }
        if (per_cu > 1) per_cu = 1;
        grid = cus * per_cu;
        (void)hipGetLastError();
    }
    if (grid < 0) return;
    Args a{};
    for (int i = 0; i < 23; ++i) a.in[i] = (const float*)d_in[i];
    a.out = (float*)d_out; a.ws = (unsigned char*)d_ws;
    void* params[] = {&a};
    hipError_t e = hipLaunchCooperativeKernel((const void*)hymba_fwd, dim3(grid), dim3(NTHR), params, LDS_BYTES, stream);
    if (e != hipSuccess) fprintf(stderr, "cooperative launch failed: %s (grid %d)\n", hipGetErrorString(e), grid);
}
```

```cpp
#include <hip/hip_runtime.h>
#include <hip/hip_cooperative_groups.h>
#include <cstdio>
#include <cstdint>
#include <cmath>
namespace cg = cooperative_groups;

constexpr int MP = 65536;
constexpr int MS = 128;
constexpr int MPAD = 65792;
constexpr int DMODEL = 1024, FFD = 4096, NIN = 3072, PROJ = 3080;
constexpr float NORM_EPS = 1e-6f;
constexpr float LOG2E = 1.4426950408889634f;
constexpr float QSCALE = 0.125f * 1.4426950408889634f;
constexpr size_t O_YP = 0, O_YS = 67108864, O_KP = 67239936, O_VP = 100794368, O_LP = 134348800, O_CP = 134873088,
                 O_KS = 134889472, O_VS = 134955008, O_LS = 135020544, O_CS = 135021568;
constexpr size_t MiB = 1u << 20;
constexpr size_t WS_WIN = 0, WS_WOUT = 6 * MiB, WS_WUP = 8 * MiB, WS_WDN = 16 * MiB;
constexpr size_t WS_MOD = 24 * MiB, WS_MODF = 24 * MiB + 640 * 1024, WS_GM2 = 24 * MiB + 896 * 1024, WS_BU = 25 * MiB;
constexpr size_t WS_SST = 25 * MiB + 512 * 1024;
constexpr size_t WS_FS = 26 * MiB, WS_FSS = 28 * MiB, WS_PART = 30 * MiB, WS_SS = 32 * MiB;
constexpr size_t WS_R1 = 40 * MiB;
constexpr size_t R1_XN = WS_R1, R1_Q = WS_R1 + (size_t)MPAD * 2048;
constexpr size_t BUF512 = (size_t)MPAD * 512;
constexpr size_t WS_X1 = WS_R1 + 514 * MiB;
constexpr size_t WS_A2 = WS_X1 + 257 * MiB;
constexpr size_t WS_END = WS_A2 + 129 * MiB;
static_assert((size_t)MPAD * 8192 == 514 * MiB, "H size");

namespace pg8 {
#define PG8_LAS __attribute__((address_space(3)))
typedef unsigned short bf16_t;
typedef short bf16x8 __attribute__((ext_vector_type(8)));
typedef float f32x4 __attribute__((ext_vector_type(4)));
typedef unsigned u32x4 __attribute__((ext_vector_type(4)));
constexpr int BM = 256, BK = 64, HALF = 128, HTB = HALF * BK * 2  , STAGE_BYTES = 8 * HTB, NXCD = 8, WGM = 8;

__host__ __device__ __forceinline__ int lds_byte(int r, int c) { const int st = (r >> 4) * 2 + (c >> 5), rr = r & 15, cc = c & 31, ob = rr * 64 + cc * 2; return st * 1024 + (ob ^ (((ob >> 9) & 1) << 5)); }
__host__ __device__ __forceinline__ void stage_rc(int b, int& R, int& C) { const int st = b / 1024, sb = b % 1024, swz = sb ^ (((sb >> 9) & 1) << 5); R = (st >> 1) * 16 + swz / 64; C = (st & 1) * 32 + (swz % 64) / 2; }
__host__ __device__ __forceinline__ int perm32(int rho) { const int n = rho >> 4, i = rho & 15; return 8 * (i >> 2) + 4 * n + (i & 3); }

struct Unit { int pm, pn; };
struct Gemm { const bf16_t* A; const bf16_t* Bt; int M, N, K; };

struct StaticOrder {
    int nM, nN, nwg, G, c;
    __host__ __device__ void init(int M, int N, int G_, int c_) { nM = M / BM; nN = N / BM; nwg = nM * nN; G = G_; c = c_; }
    __host__ __device__ bool next(int i, Unit& u) const {
        const long L = (long)i * G + c; if (L >= nwg) return false;
        int wgid = (int)L; { const int q = nwg / NXCD, r = nwg % NXCD, xcd = wgid % NXCD, off = wgid / NXCD; wgid = (xcd < r ? xcd * (q + 1) : r * (q + 1) + (xcd - r) * q) + off; }
        const int nig = WGM * nN, gid = wgid / nig, fm = gid * WGM, gsz = (nM - fm) < WGM ? (nM - fm) : WGM;
        u.pm = fm + ((wgid % nig) % gsz); u.pn = (wgid % nig) / gsz; return true;
    }
    __device__ __forceinline__ void a_ready(const Unit&) const {}
    __device__ __forceinline__ void done(const Unit&) const {}
};

__device__ __forceinline__ unsigned cvt_pk_bf16(float lo, float hi) { unsigned r; asm volatile("v_cvt_pk_bf16_f32 %0, %1, %2" : "=v"(r) : "v"(lo), "v"(hi)); return r; }
typedef float f32x2 __attribute__((ext_vector_type(2)));
__device__ __forceinline__ u32x4 pack8(const f32x4 v0, const f32x4 v1) { u32x4 w; w.x = cvt_pk_bf16(v0[0], v0[1]); w.y = cvt_pk_bf16(v0[2], v0[3]); w.z = cvt_pk_bf16(v1[0], v1[1]); w.w = cvt_pk_bf16(v1[2], v1[3]); return w; }
__device__ __forceinline__ float sumsq4(const f32x4 v) { return (v[0] * v[0] + v[1] * v[1]) + (v[2] * v[2] + v[3] * v[3]); }

struct EpiIn {
    static constexpr bool PERM = true, AFTER_DRAIN = false;
    bf16_t* QB; float* out;
    __device__ __forceinline__ void operator()(const f32x4 (&acc)[2][2][4][2], const Unit& u, int wr, int wc, int fr, int fq) const {
        const int t = u.pn >> 1;
        bf16_t* base = QB + (size_t)t * BUF512;
        const int col0 = (u.pn & 1) * 256 + wc * 32 + 8 * fq;
        const float sc = (t == 0) ? QSCALE : 1.f;
        const bool kv = (t == 1 || t == 2);
        float* fp = out + (t == 1 ? O_KP : O_VP);
        const int row0 = u.pm * BM + wr * 64 + fr;
#pragma unroll
        for (int ai = 0; ai < 2; ++ai)
#pragma unroll
            for (int m = 0; m < 4; ++m) {
                const int row = row0 + ai * HALF + m * 16;
                bf16_t* rowp = base + (size_t)row * 512 + col0;
                float* fo = nullptr;
                if (kv) fo = fp + (size_t)row * 512 + col0;
#pragma unroll
                for (int bj = 0; bj < 2; ++bj) {
                    const f32x4 v0 = acc[ai][bj][m][0] * sc, v1 = acc[ai][bj][m][1] * sc;
                    *(u32x4*)(rowp + bj * HALF) = pack8(v0, v1);
                    if (fo) { *(f32x4*)(fo + bj * HALF) = v0; *(f32x4*)(fo + bj * HALF + 4) = v1; }
                }
            }
    }
};
struct EpiOut {
    static constexpr bool PERM = true, AFTER_DRAIN = false;
    const float* xp; const float* mod; const float* gm2; float* X1; bf16_t* A2; float* SS;
    __device__ __forceinline__ void operator()(const f32x4 (&acc)[2][2][4][2], const Unit& u, int wr, int wc, int fr, int fq) const {
        const int col0 = u.pn * BM + wc * 32 + 8 * fq;
        const int row0 = u.pm * BM + wr * 64 + fr;
        const int mr = u.pm >> 4;
        const float* gt = mod + (size_t)mr * 6144 + 2048 + col0; const float* gm = gm2 + (size_t)mr * 1024 + col0;
        f32x4 gtv[2][2], gmv[2][2];
#pragma unroll
        for (int bj = 0; bj < 2; ++bj) { gtv[bj][0] = *(const f32x4*)(gt + bj * HALF); gtv[bj][1] = *(const f32x4*)(gt + bj * HALF + 4); gmv[bj][0] = *(const f32x4*)(gm + bj * HALF); gmv[bj][1] = *(const f32x4*)(gm + bj * HALF + 4); }
#pragma unroll
        for (int ai = 0; ai < 2; ++ai)
#pragma unroll
            for (int m = 0; m < 4; ++m) {
                const int row = row0 + ai * HALF + m * 16;
                const float* xr = xp + (size_t)row * 1024 + col0;
                f32x4 xv[2][2];
#pragma unroll
                for (int bj = 0; bj < 2; ++bj) { xv[bj][0] = *(const f32x4*)(xr + bj * HALF); xv[bj][1] = *(const f32x4*)(xr + bj * HALF + 4); }
                float s = 0.f;
#pragma unroll
                for (int bj = 0; bj < 2; ++bj) {
                    const int c = col0 + bj * HALF;
                    const f32x4 r0 = xv[bj][0] + gtv[bj][0] * acc[ai][bj][m][0], r1 = xv[bj][1] + gtv[bj][1] * acc[ai][bj][m][1];
                    *(f32x4*)(X1 + (size_t)row * 1024 + c) = r0; *(f32x4*)(X1 + (size_t)row * 1024 + c + 4) = r1;
                    s += sumsq4(r0) + sumsq4(r1);
                    *(u32x4*)(A2 + (size_t)row * 1024 + c) = pack8(r0 * gmv[bj][0], r1 * gmv[bj][1]);
                }
                s += __shfl_xor(s, 16); s += __shfl_xor(s, 32);
                if (fq == 0) SS[(size_t)row * 16 + u.pn * 4 + wc] = s;
            }
    }
};
struct EpiUp {
    static constexpr bool PERM = true, AFTER_DRAIN = false;
    const float* SS; const float* BU; bf16_t* H; PG8_LAS float* rtab;
    __device__ __forceinline__ void operator()(const f32x4 (&acc)[2][2][4][2], const Unit& u, int wr, int wc, int fr, int fq) const {
        const int col0 = u.pn * BM + wc * 32 + 8 * fq;
        const int row0 = u.pm * BM + wr * 64 + fr;
        { const int t = (wr * 4 + wc) * 64 + fq * 16 + fr;
          if (t < 256) { const f32x4* sp = (const f32x4*)(SS + (size_t)(u.pm * BM + t) * 16); const f32x4 s4 = (sp[0] + sp[1]) + (sp[2] + sp[3]);
              rtab[t] = 1.0f / sqrtf(((s4[0] + s4[1]) + (s4[2] + s4[3])) * (1.0f / 1024.0f) + NORM_EPS); } }
        const float* bu = BU + (size_t)(u.pm >> 4) * 4096 + col0;
        f32x4 bv[2][2];
#pragma unroll
        for (int bj = 0; bj < 2; ++bj) { bv[bj][0] = *(const f32x4*)(bu + bj * HALF); bv[bj][1] = *(const f32x4*)(bu + bj * HALF + 4); }
        asm volatile("s_waitcnt lgkmcnt(0)" ::: "memory"); __builtin_amdgcn_s_barrier(); asm volatile("" ::: "memory");
#pragma unroll
        for (int ai = 0; ai < 2; ++ai)
#pragma unroll
            for (int m = 0; m < 4; ++m) {
                const int row = row0 + ai * HALF + m * 16;
                const float rstd = rtab[ai * HALF + wr * 64 + m * 16 + fr];
#pragma unroll
                for (int bj = 0; bj < 2; ++bj) {
                    const int c = col0 + bj * HALF;
                    f32x4 v0 = acc[ai][bj][m][0] * rstd + bv[bj][0], v1 = acc[ai][bj][m][1] * rstd + bv[bj][1];
#pragma unroll
                    for (int j = 0; j < 4; ++j) { const float a = fmaxf(v0[j], 0.f), b = fmaxf(v1[j], 0.f); v0[j] = a * a; v1[j] = b * b; }
                    *(u32x4*)(H + (size_t)row * 4096 + c) = pack8(v0, v1);
                }
            }
    }
};
struct EpiDown {
    static constexpr bool PERM = true, AFTER_DRAIN = false;
    const float* mod; float* X1;
    __device__ __forceinline__ void operator()(const f32x4 (&acc)[2][2][4][2], const Unit& u, int wr, int wc, int fr, int fq) const {
        const int col0 = u.pn * BM + wc * 32 + 8 * fq;
        const int row0 = u.pm * BM + wr * 64 + fr;
        const float* gt = mod + (size_t)(u.pm >> 4) * 6144 + 5120 + col0;
        f32x4 gtv[2][2];
#pragma unroll
        for (int bj = 0; bj < 2; ++bj) { gtv[bj][0] = *(const f32x4*)(gt + bj * HALF); gtv[bj][1] = *(const f32x4*)(gt + bj * HALF + 4); }
#pragma unroll
        for (int ai = 0; ai < 2; ++ai)
#pragma unroll
            for (int m = 0; m < 4; ++m) {
                float* xr = X1 + (size_t)(row0 + ai * HALF + m * 16) * 1024 + col0;
                f32x4 xv[2][2];
#pragma unroll
                for (int bj = 0; bj < 2; ++bj) { xv[bj][0] = *(const f32x4*)(xr + bj * HALF); xv[bj][1] = *(const f32x4*)(xr + bj * HALF + 4); }
#pragma unroll
                for (int bj = 0; bj < 2; ++bj) { *(f32x4*)(xr + bj * HALF) = xv[bj][0] + gtv[bj][0] * acc[ai][bj][m][0]; *(f32x4*)(xr + bj * HALF + 4) = xv[bj][1] + gtv[bj][1] * acc[ai][bj][m][1]; }
            }
    }
};

template <class Epi, class Sched, bool ALIGN_EPI = false, bool SP2 = false>
__device__ __forceinline__ void gemm_phase(PG8_LAS unsigned char* lds, const Gemm g, const Sched& S, const Epi& E) {
    int tid_ = threadIdx.x; asm volatile("" : "+v"(tid_));
    const int tid = tid_, wid = __builtin_amdgcn_readfirstlane(tid >> 6), lane = tid & 63, wr = wid >> 2, wc = wid & 3, fr = lane & 15, fq = lane >> 4;
    const int K = g.K, nt = K / BK;
    unsigned voffA[2], voffB[2];
#pragma unroll
    for (int i = 0; i < 2; ++i) { int R, C; stage_rc(tid * 16 + i * 8192, R, C); const int Rb = Epi::PERM ? ((R & ~31) + perm32(R & 31)) : R;
        voffA[i] = (unsigned)(R * K + C) * 2u; voffB[i] = (unsigned)(Rb * K + C) * 2u; }
    const size_t kstep = (size_t)(BK * 2);
    const size_t hstep = (size_t)HALF * K * 2;
    const size_t tstep = 2 * hstep;
    const unsigned ldsw = (unsigned)wid * 1024u;
    const int aoff = lds_byte(wr * 64 + fr, fq * 8), boff = lds_byte(wc * 32 + fr, fq * 8);
#define PG8_SA(b, h) (((b) * 2 + (h)) * HTB)
#define PG8_SB(b, h) ((4 + (b) * 2 + (h)) * HTB)
#define PG8_STAGE(bufoff, gbase, voff) do { _Pragma("unroll") for (int _i = 0; _i < 2; ++_i) \
        __builtin_amdgcn_global_load_lds((const unsigned*)((const char*)(gbase) + (voff)[_i]), (PG8_LAS unsigned*)(lds + (bufoff) + ldsw + _i * 8192), 16, 0, 0); } while (0)
#define PG8_LDA(dst, b, h) do { _Pragma("unroll") for (int m = 0; m < 4; ++m) _Pragma("unroll") for (int k = 0; k < 2; ++k) dst[m][k] = *(const PG8_LAS bf16x8*)(lds + PG8_SA(b, h) + aoff + m * 2048 + k * 1024); } while (0)
#define PG8_LDB(dst, b, h) do { _Pragma("unroll") for (int n = 0; n < 2; ++n) _Pragma("unroll") for (int k = 0; k < 2; ++k) dst[n][k] = *(const PG8_LAS bf16x8*)(lds + PG8_SB(b, h) + boff + n * 2048 + k * 1024); } while (0)
#define PG8_MMA(ai, bj, At, Bt) do { __builtin_amdgcn_s_setprio(1); _Pragma("unroll") for (int m = 0; m < 4; ++m) _Pragma("unroll") for (int n = 0; n < 2; ++n) _Pragma("unroll") for (int k = 0; k < 2; ++k) \
        acc[ai][bj][m][n] = __builtin_amdgcn_mfma_f32_16x16x32_bf16(Bt[n][k], At[m][k], acc[ai][bj][m][n], 0, 0, 0); __builtin_amdgcn_s_setprio(0); } while (0)
#define PG8_WAIT_V(n) asm volatile("s_waitcnt vmcnt(" #n ")" ::: "memory")
#define PG8_WAIT_L(n) asm volatile("s_waitcnt lgkmcnt(" #n ")" ::: "memory")
#define PG8_BAR __builtin_amdgcn_s_barrier()
#define PG8_SCHED __builtin_amdgcn_sched_barrier(0)
    Unit cur, nxt; int ui = 0;
    if (!S.next(0, cur)) return;
    f32x4 acc[2][2][4][2];
#pragma unroll
    for (int a = 0; a < 2; ++a)
#pragma unroll
        for (int b = 0; b < 2; ++b)
#pragma unroll
            for (int m = 0; m < 4; ++m)
#pragma unroll
                for (int n = 0; n < 2; ++n) acc[a][b][m][n] = (f32x4){0.f, 0.f, 0.f, 0.f};
    bf16x8 At[4][2], B0[2][2], B1[2][2];
    const char* cA = (const char*)g.A + (size_t)cur.pm * tstep; const char* cB = (const char*)g.Bt + (size_t)cur.pn * tstep;
    S.a_ready(cur);
    if constexpr (SP2) {
        PG8_STAGE(PG8_SB(0, 0), cB, voffB); PG8_STAGE(PG8_SB(0, 1), cB + hstep, voffB); PG8_STAGE(PG8_SA(0, 0), cA, voffA); PG8_STAGE(PG8_SA(0, 1), cA + hstep, voffA);
        if (wr == 1) PG8_BAR;
        PG8_WAIT_V(2); PG8_BAR;
        PG8_STAGE(PG8_SB(1, 0), cB + kstep, voffB); PG8_STAGE(PG8_SA(1, 0), cA + kstep, voffA); PG8_STAGE(PG8_SB(1, 1), cB + hstep + kstep, voffB);
        PG8_WAIT_V(6); PG8_BAR;
    } else {
        PG8_STAGE(PG8_SB(0, 0), cB, voffB); PG8_STAGE(PG8_SA(0, 0), cA, voffA); PG8_STAGE(PG8_SB(0, 1), cB + hstep, voffB); PG8_STAGE(PG8_SA(0, 1), cA + hstep, voffA);
        if (wr == 1) PG8_BAR;
        PG8_WAIT_V(4); PG8_BAR;
        PG8_STAGE(PG8_SB(1, 0), cB + kstep, voffB); PG8_STAGE(PG8_SA(1, 0), cA + kstep, voffA); PG8_STAGE(PG8_SB(1, 1), cB + hstep + kstep, voffB);
        PG8_WAIT_V(6); PG8_BAR;
    }
    for (;;) {
        const bool has_next = S.next(ui + 1, nxt);
        const char* nA = has_next ? (const char*)g.A + (size_t)nxt.pm * tstep : cA; const char* nB = has_next ? (const char*)g.Bt + (size_t)nxt.pn * tstep : cB;
        for (int t = 0; t < nt; t += 2) {
            const bool last = (t == nt - 2);
            const char* a1 = cA + (size_t)(t + 1) * kstep;
            const char* a2 = last ? nA : cA + (size_t)(t + 2) * kstep; const char* b2 = last ? nB : cB + (size_t)(t + 2) * kstep;
            const char* a3 = a2 + kstep; const char* b3 = b2 + kstep;
            if (last && has_next) S.a_ready(nxt);
            if constexpr (SP2) {
            PG8_LDB(B0, 0, 0); PG8_LDB(B1, 0, 1); PG8_SCHED; PG8_LDA(At, 0, 0); PG8_STAGE(PG8_SA(1, 1), a1 + hstep, voffA);
            PG8_WAIT_V(8); PG8_WAIT_L(0); PG8_BAR; PG8_MMA(0, 0, At, B0); PG8_MMA(0, 1, At, B1); PG8_BAR; PG8_SCHED;
            PG8_LDA(At, 0, 1); PG8_STAGE(PG8_SB(0, 0), b2, voffB); PG8_STAGE(PG8_SB(0, 1), b2 + hstep, voffB); PG8_STAGE(PG8_SA(0, 0), a2, voffA);
            PG8_WAIT_V(8); PG8_WAIT_L(0); PG8_BAR; PG8_MMA(1, 0, At, B0); PG8_MMA(1, 1, At, B1); PG8_BAR; PG8_SCHED;
            PG8_LDB(B0, 1, 0); PG8_LDB(B1, 1, 1); PG8_SCHED; PG8_LDA(At, 1, 0); PG8_STAGE(PG8_SA(0, 1), a2 + hstep, voffA);
            PG8_WAIT_V(8); PG8_WAIT_L(0); PG8_BAR; PG8_MMA(0, 0, At, B0); PG8_MMA(0, 1, At, B1); PG8_BAR; PG8_SCHED;
            PG8_LDA(At, 1, 1); PG8_STAGE(PG8_SB(1, 0), b3, voffB); PG8_STAGE(PG8_SB(1, 1), b3 + hstep, voffB); PG8_STAGE(PG8_SA(1, 0), a3, voffA);
            PG8_WAIT_V(8); PG8_WAIT_L(0); PG8_BAR; PG8_MMA(1, 0, At, B0); PG8_MMA(1, 1, At, B1); PG8_BAR; PG8_SCHED;
            } else {
            PG8_LDB(B0, 0, 0); PG8_SCHED; PG8_LDA(At, 0, 0); PG8_STAGE(PG8_SA(1, 1), a1 + hstep, voffA);
            PG8_WAIT_L(8); PG8_BAR; PG8_WAIT_L(0); PG8_MMA(0, 0, At, B0); PG8_BAR; PG8_SCHED;
            PG8_LDB(B1, 0, 1); PG8_STAGE(PG8_SB(0, 0), b2, voffB);
            PG8_BAR; PG8_WAIT_L(0); PG8_MMA(0, 1, At, B1); PG8_BAR;
            PG8_LDA(At, 0, 1); PG8_STAGE(PG8_SA(0, 0), a2, voffA);
            PG8_BAR; PG8_WAIT_L(0); PG8_MMA(1, 0, At, B0); PG8_BAR; PG8_SCHED;
            PG8_STAGE(PG8_SB(0, 1), b2 + hstep, voffB);
            PG8_WAIT_V(6); PG8_BAR; PG8_MMA(1, 1, At, B1); PG8_BAR;
            PG8_LDB(B0, 1, 0); PG8_SCHED; PG8_LDA(At, 1, 0); PG8_STAGE(PG8_SA(0, 1), a2 + hstep, voffA);
            PG8_WAIT_L(8); PG8_BAR; PG8_WAIT_L(0); PG8_MMA(0, 0, At, B0); PG8_BAR; PG8_SCHED;
            PG8_LDB(B1, 1, 1); PG8_STAGE(PG8_SB(1, 0), b3, voffB);
            PG8_BAR; PG8_WAIT_L(0); PG8_MMA(0, 1, At, B1); PG8_BAR;
            PG8_LDA(At, 1, 1); PG8_STAGE(PG8_SA(1, 0), a3, voffA);
            PG8_BAR; PG8_WAIT_L(0); PG8_MMA(1, 0, At, B0); PG8_BAR; PG8_SCHED;
            PG8_STAGE(PG8_SB(1, 1), b3 + hstep, voffB);
            PG8_WAIT_V(6); PG8_BAR; PG8_MMA(1, 1, At, B1); PG8_BAR;
            }
        }
        if constexpr (ALIGN_EPI) { if (wr == 0) PG8_BAR; }
        if constexpr (!Epi::AFTER_DRAIN) { E(acc, cur, wr, wc, fr, fq); S.done(cur); }
        if (!has_next) break;
#pragma unroll
        for (int a = 0; a < 2; ++a)
#pragma unroll
            for (int b = 0; b < 2; ++b)
#pragma unroll
                for (int m = 0; m < 4; ++m)
#pragma unroll
                    for (int n = 0; n < 2; ++n) acc[a][b][m][n] = (f32x4){0.f, 0.f, 0.f, 0.f};
        cur = nxt; cA = nA; cB = nB; ++ui;
        if constexpr (ALIGN_EPI) { if (wr == 1) PG8_BAR; }
    }
    PG8_WAIT_V(0);
    if constexpr (!ALIGN_EPI) { if (wr == 0) PG8_BAR; }
    PG8_BAR;
    if constexpr (Epi::AFTER_DRAIN) { E.fused(acc, cur, wr, wc, fr, fq, lds, wid, lane); S.done(cur); }
#undef PG8_SA
#undef PG8_SB
#undef PG8_STAGE
#undef PG8_LDA
#undef PG8_LDB
#undef PG8_MMA
#undef PG8_WAIT_V
#undef PG8_WAIT_L
#undef PG8_BAR
#undef PG8_SCHED
}
}

#define LAS __attribute__((address_space(3)))
typedef unsigned short bf16;
typedef float f32x4 __attribute__((ext_vector_type(4)));
typedef unsigned u32x4 __attribute__((ext_vector_type(4)));
typedef unsigned u32x2 __attribute__((ext_vector_type(2)));
typedef short bf16x8 __attribute__((ext_vector_type(8)));
typedef short s16x4 __attribute__((ext_vector_type(4)));
typedef float f32x16 __attribute__((ext_vector_type(16)));
#define LDS_WAIT() asm volatile("s_waitcnt lgkmcnt(0)" ::: "memory")
__device__ __forceinline__ float wave_sum(float v) {
#pragma unroll
    for (int o = 1; o < 64; o <<= 1) v += __shfl_xor(v, o);
    return v;
}
__device__ __forceinline__ float wave_max(float v) {
#pragma unroll
    for (int o = 1; o < 64; o <<= 1) v = fmaxf(v, __shfl_xor(v, o));
    return v;
}
__device__ __forceinline__ float bf2f(unsigned b) { return __uint_as_float(b << 16); }
__device__ __forceinline__ unsigned f2bf(float f) { unsigned u = __float_as_uint(f); return (u + 0x7fffu + ((u >> 16) & 1u)) >> 16; }
__device__ __forceinline__ unsigned pk2(float lo, float hi) { return pg8::cvt_pk_bf16(lo, hi); }
__device__ __forceinline__ void unpack8(const u32x4 w, float (&v)[8]) {
    v[0] = bf2f(w.x & 0xffffu); v[1] = __uint_as_float(w.x & 0xffff0000u); v[2] = bf2f(w.y & 0xffffu); v[3] = __uint_as_float(w.y & 0xffff0000u);
    v[4] = bf2f(w.z & 0xffffu); v[5] = __uint_as_float(w.z & 0xffff0000u); v[6] = bf2f(w.w & 0xffffu); v[7] = __uint_as_float(w.w & 0xffff0000u);
}
__device__ __forceinline__ u32x4 pack8f(const float (&v)[8]) { u32x4 w; w.x = pk2(v[0], v[1]); w.y = pk2(v[2], v[3]); w.z = pk2(v[4], v[5]); w.w = pk2(v[6], v[7]); return w; }

struct Args { const float* in[23]; float* out; unsigned char* ws; };
enum { I_XP = 0, I_XS, I_CK, I_CV, I_CLF, I_CCONV, I_CP, I_CS, I_WADA, I_BADA, I_G1, I_G2, I_WIN, I_BF, I_WCONV, I_GATT, I_GCONV, I_WOUT, I_WUP, I_WDN, I_WADAF, I_BADAF, I_GF };

constexpr int NWAVES = 8, NTHR = 512;
constexpr int RING_BYTES = 131072, LDS_BYTES = 147456;

__device__ __forceinline__ void gemv24_group(const LAS float* A, LAS float* red, const float* W, int pitch, int col0, const float* bias, float* out, int opitch, int tid) {
    const int c = tid & 31, kg = tid >> 5;
    float acc[24];
#pragma unroll
    for (int r = 0; r < 24; ++r) acc[r] = 0.f;
    const float* wp = W + (size_t)(kg * 64) * pitch + col0 + c;
    const LAS float* ap = A + kg * 64;
#pragma unroll 2
    for (int k4 = 0; k4 < 16; ++k4) {
        const float w0 = wp[0], w1 = wp[pitch], w2 = wp[2 * (size_t)pitch], w3 = wp[3 * (size_t)pitch]; wp += 4 * (size_t)pitch;
#pragma unroll
        for (int r = 0; r < 24; ++r) { const f32x4 a = *(const LAS f32x4*)(ap + r * 1024 + k4 * 4); acc[r] += (a[0] * w0 + a[1] * w1) + (a[2] * w2 + a[3] * w3); }
    }
#pragma unroll
    for (int r = 0; r < 24; ++r) acc[r] += __shfl_xor(acc[r], 32);
    const int wid = tid >> 6, lane = tid & 63;
    if (lane < 32) {
#pragma unroll
        for (int r = 0; r < 24; ++r) red[(wid * 24 + r) * 32 + c] = acc[r];
    }
    __syncthreads();
    for (int o = tid; o < 768; o += NTHR) {
        const int r = o >> 5, cc = o & 31; float s = 0.f;
#pragma unroll
        for (int w = 0; w < 8; ++w) s += red[(w * 24 + r) * 32 + cc];
        if (bias) s += bias[col0 + cc];
        out[(size_t)r * opitch + col0 + cc] = s;
    }
    __syncthreads();
}

__device__ __forceinline__ void transpose_item(const float* W, int pitch, int K, bf16* WT, int k0, int nsrc0, int ndst0, LAS float* scr, int lane) {
#pragma unroll 8
    for (int i = 0; i < 32; ++i) { const int kk = 2 * i + (lane >> 5); scr[kk * 33 + (lane & 31)] = W[(size_t)(k0 + kk) * pitch + nsrc0 + (lane & 31)]; }
    LDS_WAIT(); asm volatile("" ::: "memory");
    const int c = lane & 7;
#pragma unroll
    for (int j = 0; j < 4; ++j) { const int n = (lane >> 3) + 8 * j; const LAS float* s = scr + (8 * c) * 33 + n;
        u32x4 o; o.x = pk2(s[0 * 33], s[1 * 33]); o.y = pk2(s[2 * 33], s[3 * 33]); o.z = pk2(s[4 * 33], s[5 * 33]); o.w = pk2(s[6 * 33], s[7 * 33]);
        *(u32x4*)(WT + (size_t)(ndst0 + n) * K + k0 + 8 * c) = o; }
    LDS_WAIT(); asm volatile("" ::: "memory");
}

namespace att {
constexpr int SEQ = 4096, D = 64, DM = 512, QB = 256, QBLK = 32, KVBLK = 64, NW = 8;
constexpr int SLOTB = 8192;
constexpr int NSLOT = 3;
constexpr int LDS_K = 0, LDS_V = NSLOT * SLOTB, LDS_WS = 2 * NSLOT * SLOTB, LDS_OST = LDS_WS + 2048, LDS_F = LDS_OST + NW * 4096, LDS_END = LDS_F + 16384;
static_assert(LDS_END <= RING_BYTES, "attention LDS");
__device__ __forceinline__ int crow(int r, int hi) { return (r & 3) + 8 * (r >> 2) + 4 * hi; }
__device__ __forceinline__ void cmask(f32x16& p0, f32x16& p1, int jb, int qrel, int hi) {
    const float NEG = -INFINITY; const int kb = 64 * jb + 4 * hi;
#pragma unroll
    for (int r = 0; r < 16; ++r) { const int kv = kb + (r & 3) + 8 * (r >> 2); if (kv > qrel) p0[r] = NEG; if (kv + 32 > qrel) p1[r] = NEG; }
}
__device__ __forceinline__ void glds16(const void* gsrc, unsigned lds_dst) { unsigned keep;
    asm volatile("s_mov_b32 %0, m0\n\ts_mov_b32 m0, %2\n\ts_nop 0\n\tglobal_load_lds_dwordx4 %1, off\n\ts_mov_b32 m0, %0" : "=&s"(keep) : "v"(gsrc), "s"(lds_dst) : "memory"); }
__device__ __forceinline__ float max3f(float a, float b, float c) { return fmaxf(fmaxf(a, b), c); }
__device__ __forceinline__ float rowmax(const f32x16& p0, const f32x16& p1) {
    float a = max3f(p0[0], p0[1], p1[0]), b = max3f(p0[2], p0[3], p1[1]); a = max3f(a, p1[2], p1[3]);
#pragma unroll
    for (int r = 4; r < 16; r += 4) { a = max3f(a, p0[r], p0[r + 1]); b = max3f(b, p0[r + 2], p0[r + 3]); a = max3f(a, p1[r], p1[r + 1]); b = max3f(b, p1[r + 2], p1[r + 3]); }
    const float m = fmaxf(a, b);
    auto rr = __builtin_amdgcn_permlane32_swap(__float_as_uint(m), __float_as_uint(m), false, false);
    return fmaxf(__uint_as_float(rr[0]), __uint_as_float(rr[1]));
}
#define ATT_WAIT_BAR0() asm volatile("s_waitcnt vmcnt(0) lgkmcnt(0)\n\ts_barrier" ::: "memory")
__device__ __forceinline__ void qkt(f32x16& p0, f32x16& p1, const LAS char* Kslot, const bf16x8* qr, const f32x16& cin, int r32, int hi) {
    const LAS char* kb = Kslot + hi * 1024 + r32 * 16;
#pragma unroll
    for (int d0 = 0; d0 < 4; ++d0) {
        const bf16x8 b0 = *(const LAS bf16x8*)(kb + d0 * 2048);
        const bf16x8 b1 = *(const LAS bf16x8*)(kb + d0 * 2048 + 512);
        if (d0 == 0) { p0 = __builtin_amdgcn_mfma_f32_32x32x16_bf16(b0, qr[0], cin, 0, 0, 0); p1 = __builtin_amdgcn_mfma_f32_32x32x16_bf16(b1, qr[0], cin, 0, 0, 0); }
        else { p0 = __builtin_amdgcn_mfma_f32_32x32x16_bf16(b0, qr[d0], p0, 0, 0, 0); p1 = __builtin_amdgcn_mfma_f32_32x32x16_bf16(b1, qr[d0], p1, 0, 0, 0); }
    }
}
__device__ __forceinline__ void pv(f32x16* o, int vb, bf16x8 pa0, bf16x8 pa1, bf16x8 pa2, bf16x8 pa3) {
    s16x4 lo[2][4], hi[2][4];
#pragma unroll
    for (int d0 = 0; d0 < 2; ++d0)
#pragma unroll
        for (int ks = 0; ks < 4; ++ks) {
            asm volatile("ds_read_b64_tr_b16 %0,%1 offset:%c2" : "=&v"(lo[d0][ks]) : "v"(vb), "i"(d0 * 4096 + ks * 1024) : "memory");
            asm volatile("ds_read_b64_tr_b16 %0,%1 offset:%c2" : "=&v"(hi[d0][ks]) : "v"(vb), "i"(d0 * 4096 + ks * 1024 + 512) : "memory"); }
    asm volatile("s_waitcnt lgkmcnt(0)" ::: "memory"); __builtin_amdgcn_sched_barrier(0);
#define ATT_PK(d, k) (bf16x8){lo[d][k][0], lo[d][k][1], lo[d][k][2], lo[d][k][3], hi[d][k][0], hi[d][k][1], hi[d][k][2], hi[d][k][3]}
    o[0] = __builtin_amdgcn_mfma_f32_32x32x16_bf16(pa0, ATT_PK(0, 0), o[0], 0, 0, 0);
    o[1] = __builtin_amdgcn_mfma_f32_32x32x16_bf16(pa0, ATT_PK(1, 0), o[1], 0, 0, 0);
    o[0] = __builtin_amdgcn_mfma_f32_32x32x16_bf16(pa1, ATT_PK(0, 1), o[0], 0, 0, 0);
    o[1] = __builtin_amdgcn_mfma_f32_32x32x16_bf16(pa1, ATT_PK(1, 1), o[1], 0, 0, 0);
    o[0] = __builtin_amdgcn_mfma_f32_32x32x16_bf16(pa2, ATT_PK(0, 2), o[0], 0, 0, 0);
    o[1] = __builtin_amdgcn_mfma_f32_32x32x16_bf16(pa2, ATT_PK(1, 2), o[1], 0, 0, 0);
    o[0] = __builtin_amdgcn_mfma_f32_32x32x16_bf16(pa3, ATT_PK(0, 3), o[0], 0, 0, 0);
    o[1] = __builtin_amdgcn_mfma_f32_32x32x16_bf16(pa3, ATT_PK(1, 3), o[1], 0, 0, 0);
#undef ATT_PK
}
typedef short v4i16_t __attribute__((ext_vector_type(4)));
__device__ __forceinline__ s16x4 vtr(const LAS char* p) { return __builtin_bit_cast(s16x4, __builtin_amdgcn_ds_read_tr16_b64_v4i16((LAS v4i16_t*)p)); }
#define SGB(mask, n) __builtin_amdgcn_sched_group_barrier(mask, n, 0)
template <bool MASK, bool HASNEXT>
__device__ __forceinline__ void att_step(f32x16& p0, f32x16& p1, f32x16& n0, f32x16& n1, f32x16 (&o)[2], float& l_reg, float& mref, f32x16& cin, const bf16x8 (&qr)[4],
                                         const LAS char* Kn, const LAS char* Vc, const LAS float* Fn, int jbn, int qrel, int r32, int hi, float fqv, LAS float* wsf) {
    bf16x8 kf[8];
    if constexpr (HASNEXT) {
        const LAS char* kb = Kn + hi * 1024 + r32 * 16;
#pragma unroll
        for (int d0 = 0; d0 < 4; ++d0) { kf[2 * d0] = *(const LAS bf16x8*)(kb + d0 * 2048); kf[2 * d0 + 1] = *(const LAS bf16x8*)(kb + d0 * 2048 + 512); }
    }
    if constexpr (HASNEXT) {
        n0 = __builtin_amdgcn_mfma_f32_32x32x16_bf16(kf[0], qr[0], cin, 0, 0, 0); n1 = __builtin_amdgcn_mfma_f32_32x32x16_bf16(kf[1], qr[0], cin, 0, 0, 0);
#pragma unroll
        for (int d0 = 1; d0 < 4; ++d0) { n0 = __builtin_amdgcn_mfma_f32_32x32x16_bf16(kf[2 * d0], qr[d0], n0, 0, 0, 0); n1 = __builtin_amdgcn_mfma_f32_32x32x16_bf16(kf[2 * d0 + 1], qr[d0], n1, 0, 0, 0); }
    }
    float sacc = 0.f;
#pragma unroll
    for (int r = 0; r < 16; ++r) { p0[r] = __builtin_amdgcn_exp2f(p0[r]); p1[r] = __builtin_amdgcn_exp2f(p1[r]); }
#pragma unroll
    for (int r = 0; r < 16; ++r) sacc += p0[r] + p1[r];
    l_reg += sacc;
    u32x4 pw0, pw1, pw2, pw3;
    pw0 = (u32x4){pk2(p0[0], p0[1]), pk2(p0[2], p0[3]), pk2(p0[4], p0[5]), pk2(p0[6], p0[7])};
    pw1 = (u32x4){pk2(p0[8], p0[9]), pk2(p0[10], p0[11]), pk2(p0[12], p0[13]), pk2(p0[14], p0[15])};
    pw2 = (u32x4){pk2(p1[0], p1[1]), pk2(p1[2], p1[3]), pk2(p1[4], p1[5]), pk2(p1[6], p1[7])};
    pw3 = (u32x4){pk2(p1[8], p1[9]), pk2(p1[10], p1[11]), pk2(p1[12], p1[13]), pk2(p1[14], p1[15])};
    if constexpr (HASNEXT) {
#pragma unroll
        for (int i = 0; i < 8; ++i) { SGB(0x008, 1); SGB(0x400, 4); SGB(0x002, 6); }
    }
    __builtin_amdgcn_sched_barrier(0);
    s16x4 vlo[2][4], vhi[2][4];
#pragma unroll
    for (int d0 = 0; d0 < 2; ++d0)
#pragma unroll
        for (int ks = 0; ks < 4; ++ks) { vlo[d0][ks] = vtr(Vc + d0 * 4096 + ks * 1024); vhi[d0][ks] = vtr(Vc + d0 * 4096 + ks * 1024 + 512); }
    const bf16x8 pa[4] = {__builtin_bit_cast(bf16x8, pw0), __builtin_bit_cast(bf16x8, pw1), __builtin_bit_cast(bf16x8, pw2), __builtin_bit_cast(bf16x8, pw3)};
#define ATT_VF(d, k) (bf16x8){vlo[d][k][0], vlo[d][k][1], vlo[d][k][2], vlo[d][k][3], vhi[d][k][0], vhi[d][k][1], vhi[d][k][2], vhi[d][k][3]}
#pragma unroll
    for (int ks = 0; ks < 4; ++ks) {
        o[0] = __builtin_amdgcn_mfma_f32_32x32x16_bf16(pa[ks], ATT_VF(0, ks), o[0], 0, 0, 0);
        o[1] = __builtin_amdgcn_mfma_f32_32x32x16_bf16(pa[ks], ATT_VF(1, ks), o[1], 0, 0, 0);
    }
#undef ATT_VF
    float rm = 0.f;
    if constexpr (HASNEXT) {
#pragma unroll
        for (int g = 0; g < 4; ++g) {
            const f32x4 f0 = *(const LAS f32x4*)(Fn + 8 * g + 4 * hi), f1 = *(const LAS f32x4*)(Fn + 32 + 8 * g + 4 * hi);
#pragma unroll
            for (int j = 0; j < 4; ++j) { n0[4 * g + j] -= f0[j]; n1[4 * g + j] -= f1[j]; }
        }
        if constexpr (MASK) cmask(n0, n1, jbn, qrel, hi);
        rm = rowmax(n0, n1);
#pragma unroll
        for (int i = 0; i < 8; ++i) { SGB(0x008, 1); SGB(0x002, 8); }
    }
    __builtin_amdgcn_sched_barrier(0);
    if constexpr (HASNEXT) {
        if (__any(rm > 8.0f)) {
            const float dl = fmaxf(rm, 0.f);
            mref += dl;
#pragma unroll
            for (int r = 0; r < 16; ++r) { n0[r] -= dl; n1[r] -= dl; }
#pragma unroll
            for (int r = 0; r < 16; ++r) cin[r] = fqv - mref;
            const float f = __builtin_amdgcn_exp2f(-dl); l_reg *= f;
            if (hi == 0) wsf[r32] = f;
            LDS_WAIT();
#pragma unroll
            for (int r = 0; r < 16; ++r) { const float g = wsf[crow(r, hi)]; o[0][r] *= g; o[1][r] *= g; }
        }
    }
}
__device__ __forceinline__ void attn_unit(int b, int h, int qb, const bf16* Q, const bf16* __restrict__ K, const bf16* __restrict__ V, bf16* O, const float* __restrict__ F2g, LAS char* shm) {
    int tid_ = threadIdx.x; asm volatile("" : "+v"(tid_));
    const int tid = tid_, lane = tid & 63, r32 = lane & 31, hi = lane >> 5; const int wid = __builtin_amdgcn_readfirstlane(tid >> 6);
    const long rowbase = (long)b * SEQ; const int q0 = qb * QB;
    const bf16* Qw = Q + (rowbase + q0 + wid * QBLK) * DM + h * D;
    const bf16* Kh = K + rowbase * DM + h * D, *Vh = V + rowbase * DM + h * D;
    const unsigned lds0 = (unsigned)(uintptr_t)shm;
    LAS float* wsf = (LAS float*)(shm + LDS_WS) + wid * 64;
    LAS float* Fl = (LAS float*)(shm + LDS_F);
    const bf16* ksrc = Kh + (long)lane * DM + wid * 8;
    const bf16* vsrc = Vh + (long)(16 * (wid & 3) + (lane >> 2)) * DM + (wid >> 2) * 32 + (lane & 3) * 8;
    const unsigned kdst = lds0 + LDS_K + wid * 1024, vdst = lds0 + LDS_V + wid * 1024;
#define DMA_K(t, slot) glds16(ksrc + (long)(t) * KVBLK * DM, (unsigned)__builtin_amdgcn_readfirstlane(kdst + (slot)))
#define DMA_V(t, slot) glds16(vsrc + (long)(t) * KVBLK * DM, (unsigned)__builtin_amdgcn_readfirstlane(vdst + (slot)))
    const LAS char* Kb = (const LAS char*)(shm + LDS_K);
    const LAS char* vp0 = (const LAS char*)(shm + LDS_V) + ((lane >> 4) & 1) * 32 + (lane & 3) * 8 + (4 * hi + ((lane & 15) >> 2)) * 64;
    const int NT = (q0 + QB) / KVBLK;
    DMA_K(0, 0); DMA_V(0, 0); DMA_K(1, SLOTB); DMA_V(1, SLOTB); DMA_K(2, 2 * SLOTB);
    for (int i = tid; i < NT * 64; i += NTHR) Fl[i] = F2g[i];
    bf16x8 qr[4];
#pragma unroll
    for (int d0 = 0; d0 < 4; ++d0) qr[d0] = *reinterpret_cast<const bf16x8*>(&Qw[(long)r32 * DM + d0 * 16 + hi * 8]);
    const float fqv = F2g[q0 + wid * QBLK + r32];
    f32x16 cin;
#pragma unroll
    for (int r = 0; r < 16; ++r) cin[r] = fqv;
    float mref = 0.f, l_reg = 0.f; f32x16 o[2];
#pragma unroll
    for (int r = 0; r < 16; ++r) { o[0][r] = 0.f; o[1][r] = 0.f; }
    const int qrel = wid * QBLK + r32;
    ATT_WAIT_BAR0();
    f32x16 p0, p1;
    qkt(p0, p1, Kb, qr, cin, r32, hi);
#pragma unroll
    for (int g = 0; g < 4; ++g) {
        const f32x4 f0 = *(const LAS f32x4*)(Fl + 8 * g + 4 * hi), f1 = *(const LAS f32x4*)(Fl + 32 + 8 * g + 4 * hi);
#pragma unroll
        for (int j = 0; j < 4; ++j) { p0[4 * g + j] -= f0[j]; p1[4 * g + j] -= f1[j]; }
    }
    if (NT == 4) cmask(p0, p1, 0, qrel, hi);
    { const float rm = rowmax(p0, p1); mref = rm;
#pragma unroll
      for (int r = 0; r < 16; ++r) { p0[r] -= rm; p1[r] -= rm; cin[r] = fqv - mref; } }
    int sk = SLOTB, sv = 0;
#define ATT_TOP(t) do { if ((t) + 2 < NT) asm volatile("s_waitcnt vmcnt(2) lgkmcnt(0)\n\ts_barrier" ::: "memory"); \
        else if ((t) + 1 < NT) asm volatile("s_waitcnt vmcnt(1) lgkmcnt(0)\n\ts_barrier" ::: "memory"); else ATT_WAIT_BAR0(); \
        if ((t) + 3 < NT) DMA_K((t) + 3, sv); if ((t) + 2 < NT) DMA_V((t) + 2, (sv == 0 ? 2 * SLOTB : sv - SLOTB)); } while (0)
#define ATT_ROT() do { sk = (sk == 2 * SLOTB ? 0 : sk + SLOTB); sv = (sv == 2 * SLOTB ? 0 : sv + SLOTB); } while (0)
    int t = 0;
    f32x16 pb0, pb1;
    for (; t + 6 < NT; t += 2) {
        ATT_TOP(t);
        att_step<false, true>(p0, p1, pb0, pb1, o, l_reg, mref, cin, qr, Kb + sk, vp0 + sv, Fl + 64 * (t + 1), 0, qrel, r32, hi, fqv, wsf);
        ATT_ROT();
        ATT_TOP(t + 1);
        att_step<false, true>(pb0, pb1, p0, p1, o, l_reg, mref, cin, qr, Kb + sk, vp0 + sv, Fl + 64 * (t + 2), 0, qrel, r32, hi, fqv, wsf);
        ATT_ROT();
    }
    for (; t + 5 < NT; ++t) {
        ATT_TOP(t);
        att_step<false, true>(p0, p1, pb0, pb1, o, l_reg, mref, cin, qr, Kb + sk, vp0 + sv, Fl + 64 * (t + 1), 0, qrel, r32, hi, fqv, wsf);
        p0 = pb0; p1 = pb1;
        ATT_ROT();
    }
    for (; t + 1 < NT; ++t) {
        ATT_TOP(t);
        att_step<true, true>(p0, p1, pb0, pb1, o, l_reg, mref, cin, qr, Kb + sk, vp0 + sv, Fl + 64 * (t + 1), (t + 1) - (NT - 4), qrel, r32, hi, fqv, wsf);
        p0 = pb0; p1 = pb1;
        ATT_ROT();
    }
    ATT_TOP(t);
    att_step<false, false>(p0, p1, pb0, pb1, o, l_reg, mref, cin, qr, Kb + sk, vp0 + sv, Fl, 0, qrel, r32, hi, fqv, wsf);
#undef ATT_TOP
#undef ATT_ROT
    { auto rr = __builtin_amdgcn_permlane32_swap(__float_as_uint(l_reg), __float_as_uint(l_reg), false, false); l_reg = __uint_as_float(rr[0]) + __uint_as_float(rr[1]); }
    if (hi == 0) wsf[32 + r32] = l_reg; LDS_WAIT();
    float rli[16];
#pragma unroll
    for (int r = 0; r < 16; ++r) rli[r] = __builtin_amdgcn_rcpf(wsf[32 + crow(r, hi)]);
    bf16* Ow = O + (rowbase + q0 + wid * QBLK) * DM + h * D;
    { LAS bf16* stg = (LAS bf16*)(shm + LDS_OST) + wid * 2048;
#pragma unroll
      for (int r = 0; r < 16; ++r) { const int orow = crow(r, hi);
#pragma unroll
        for (int d0 = 0; d0 < 2; ++d0) stg[orow * 64 + d0 * 32 + r32] = (bf16)f2bf(o[d0][r] * rli[r]); }
      LDS_WAIT();
#pragma unroll
      for (int i = 0; i < 4; ++i) { const int row = i * 8 + (lane >> 3), ch = lane & 7; const u32x4 v = *(const LAS u32x4*)(stg + row * 64 + ch * 8); *(u32x4*)(Ow + (long)row * DM + ch * 8) = v; } }
    asm volatile("s_waitcnt vmcnt(0) lgkmcnt(0)\n\ts_barrier" ::: "memory");
#undef DMA_K
#undef DMA_V
}
}

__device__ __forceinline__ void attn_sample_unit(int b, int h, int sp, const Args& a, LAS char* shm) {
    const int tid = threadIdx.x, lane = tid & 63; const int wid = __builtin_amdgcn_readfirstlane(tid >> 6);
    LAS float* qs = (LAS float*)shm;
    LAS float* ps = (LAS float*)(shm + 4096) + wid * 1024;
    LAS float* red = (LAS float*)(shm + 4096 + 32768);
    const bf16* Qb = (const bf16*)(a.ws + R1_Q) + (size_t)(MP + 16 * b) * 512 + h * 64;
    for (int i = tid; i < 1024; i += NTHR) qs[i] = bf2f(Qb[(i >> 6) * 512 + (i & 63)]);
    const float* F = (const float*)(a.ws + WS_FSS) + (size_t)(b * 8 + h) * 4112;
    __syncthreads();
    float m[16], ll[16], o[16];
#pragma unroll
    for (int i = 0; i < 16; ++i) { m[i] = -1e30f; ll[i] = 0.f; o[i] = 0.f; }
    const int nch = (sp == 3 && wid == 0) ? 3 : 2;
    for (int ch = 0; ch < nch; ++ch) {
        int key0, nvalid; const float* kbase; const float* vbase;
        if (ch < 2) { key0 = 1024 * sp + 128 * wid + 64 * ch; nvalid = 64; const size_t off = ((size_t)(b * 4096 + key0) * 8 + h) * 64; kbase = a.in[I_CK] + off; vbase = a.in[I_CV] + off; }
        else { key0 = 4096; nvalid = 16; const size_t off = ((size_t)(b * 16) * 8 + h) * 64; kbase = a.out + O_KS + off; vbase = a.out + O_VS + off; }
        const bool valid = lane < nvalid; const int key = key0 + lane;
        const float* kp = kbase + (size_t)(valid ? lane : 0) * 512;
        float s[16];
#pragma unroll
        for (int i = 0; i < 16; ++i) s[i] = 0.f;
#pragma unroll 4
        for (int d4 = 0; d4 < 16; ++d4) {
            const f32x4 kk = *(const f32x4*)(kp + 4 * d4);
#pragma unroll
            for (int i = 0; i < 16; ++i) { const f32x4 q4 = *(const LAS f32x4*)(qs + i * 64 + 4 * d4); s[i] += (q4[0] * kk[0] + q4[1] * kk[1]) + (q4[2] * kk[2] + q4[3] * kk[3]); }
        }
        const float fk = F[valid ? key : 0];
#pragma unroll
        for (int i = 0; i < 16; ++i) {
            float sv = s[i] + (F[4096 + i] - fk);
            if (!valid || key > 4096 + i) sv = -INFINITY;
            const float cm = wave_max(sv), mn = fmaxf(m[i], cm), al = __builtin_amdgcn_exp2f(m[i] - mn), p = __builtin_amdgcn_exp2f(sv - mn);
            ll[i] = ll[i] * al + p; o[i] *= al; m[i] = mn; s[i] = p;
        }
#pragma unroll
        for (int i4 = 0; i4 < 4; ++i4) *(LAS f32x4*)(ps + lane * 16 + 4 * i4) = (f32x4){s[4 * i4], s[4 * i4 + 1], s[4 * i4 + 2], s[4 * i4 + 3]};
        LDS_WAIT();
#pragma unroll 8
        for (int k = 0; k < nvalid; ++k) {
            const float v = vbase[(size_t)k * 512 + lane];
#pragma unroll
            for (int i4 = 0; i4 < 4; ++i4) { const f32x4 p4 = *(const LAS f32x4*)(ps + k * 16 + 4 * i4);
                o[4 * i4] += p4[0] * v; o[4 * i4 + 1] += p4[1] * v; o[4 * i4 + 2] += p4[2] * v; o[4 * i4 + 3] += p4[3] * v; }
        }
        LDS_WAIT();
    }
#pragma unroll
    for (int i = 0; i < 16; ++i) ll[i] = wave_sum(ll[i]);
#pragma unroll
    for (int i = 0; i < 16; ++i) red[(wid * 16 + i) * 66 + lane] = o[i];
    if (lane == 0) {
#pragma unroll
        for (int i = 0; i < 16; ++i) { red[(wid * 16 + i) * 66 + 64] = m[i]; red[(wid * 16 + i) * 66 + 65] = ll[i]; }
    }
    __syncthreads();
    {
        const int i = tid >> 5, dd = tid & 31;
        float M = -1e30f;
#pragma unroll
        for (int w = 0; w < 8; ++w) M = fmaxf(M, red[(w * 16 + i) * 66 + 64]);
        float L = 0.f, O0 = 0.f, O1 = 0.f;
#pragma unroll
        for (int w = 0; w < 8; ++w) { const float f = __builtin_amdgcn_exp2f(red[(w * 16 + i) * 66 + 64] - M); L += red[(w * 16 + i) * 66 + 65] * f; O0 += red[(w * 16 + i) * 66 + dd] * f; O1 += red[(w * 16 + i) * 66 + dd + 32] * f; }
        float* pp = (float*)(a.ws + WS_PART) + ((size_t)((b * 8 + h) * 4 + sp) * 16 + i) * 66;
        pp[dd] = O0; pp[dd + 32] = O1; if (dd == 0) { pp[64] = M; pp[65] = L; }
    }
    __syncthreads();
}

__device__ __forceinline__ void scan_seq(int seq, const Args& a, LAS float* sm) {
    const int tid = threadIdx.x, lane = tid & 63, wid = tid >> 6;
    const bool smp = seq >= 128; const int s = smp ? seq - 128 : seq; const int b = s >> 3, h = s & 7;
    const float* src = smp ? a.in[I_CLF] + (size_t)(b * 4096) * 8 + h : a.out + O_LP + (size_t)(b * 4096) * 8 + h;
    float v[8]; float run = 0.f;
#pragma unroll
    for (int i = 0; i < 8; ++i) { run += src[(size_t)(tid * 8 + i) * 8]; v[i] = run; }
    float inc = run;
#pragma unroll
    for (int o = 1; o < 64; o <<= 1) { const float t = __shfl_up(inc, o); if (lane >= o) inc += t; }
    if (lane == 63) sm[wid] = inc;
    __syncthreads();
    float off = inc - run;
    for (int w = 0; w < wid; ++w) off += sm[w];
    float* dst = smp ? (float*)(a.ws + WS_FSS) + (size_t)s * 4112 : (float*)(a.ws + WS_FS) + (size_t)s * 4096;
#pragma unroll
    for (int i = 0; i < 8; ++i) dst[tid * 8 + i] = (off + v[i]) * LOG2E;
    if (smp && tid == NTHR - 1) {
        float r2 = off + v[7];
        for (int i = 0; i < 16; ++i) { r2 += a.out[O_LS + (size_t)(b * 16 + i) * 8 + h]; dst[4096 + i] = r2 * LOG2E; }
    }
    __syncthreads();
}

__device__ __forceinline__ f32x4 thin_gemm(const bf16* A, int lda, const bf16* Bt, int ldb, int kbeg, int klen, int n0, int wave, int lane) {
    const int fr = lane & 15, fq = lane >> 4;
    const bf16* ap = A + (size_t)(16 * wave + fr) * lda + kbeg + 8 * fq;
    const bf16* bp = Bt + (size_t)(n0 + fr) * ldb + kbeg + 8 * fq;
    f32x4 acc0 = {0.f, 0.f, 0.f, 0.f}, acc1 = {0.f, 0.f, 0.f, 0.f};
#pragma unroll 4
    for (int k = 0; k < klen; k += 64) {
        const bf16x8 a0 = *(const bf16x8*)(ap + k), b0 = *(const bf16x8*)(bp + k), a1 = *(const bf16x8*)(ap + k + 32), b1 = *(const bf16x8*)(bp + k + 32);
        acc0 = __builtin_amdgcn_mfma_f32_16x16x32_bf16(b0, a0, acc0, 0, 0, 0);
        acc1 = __builtin_amdgcn_mfma_f32_16x16x32_bf16(b1, a1, acc1, 0, 0, 0);
    }
    return acc0 + acc1;
}

#ifndef REP_GEMM
#define REP_GEMM 1
#endif
__global__ void __launch_bounds__(NTHR, 2) hymba_fwd(Args a) {
    extern __shared__ __attribute__((aligned(16))) unsigned char lds_raw[];
    LAS unsigned char* lds = (LAS unsigned char*)lds_raw;
    cg::grid_group grid = cg::this_grid();
    const int tid = threadIdx.x, lane = tid & 63; const int wave = __builtin_amdgcn_readfirstlane(tid >> 6);
    const int G = gridDim.x, bx = blockIdx.x;
    const int vcu = (G % 8 == 0) ? (bx % 8) * (G / 8) + bx / 8 : bx;
    const int gw = vcu * NWAVES + wave, NGW = G * NWAVES;
    unsigned char* ws = a.ws;
    float* mod = (float*)(ws + WS_MOD); float* modf = (float*)(ws + WS_MODF); float* gm2 = (float*)(ws + WS_GM2); float* BU = (float*)(ws + WS_BU);
    bf16* Win_t = (bf16*)(ws + WS_WIN); bf16* Wout_t = (bf16*)(ws + WS_WOUT); bf16* Wup_t = (bf16*)(ws + WS_WUP); bf16* Wdn_t = (bf16*)(ws + WS_WDN);
    bf16* XN = (bf16*)(ws + R1_XN); bf16* QB = (bf16*)(ws + R1_Q); bf16* Hb = (bf16*)(ws + WS_R1);
    float* SST = (float*)(ws + WS_SST);
    float* X1 = (float*)(ws + WS_X1); bf16* A2 = (bf16*)(ws + WS_A2); float* SS = (float*)(ws + WS_SS);

    {
        LAS float* A = (LAS float*)lds; LAS float* red = (LAS float*)(lds + 98304);
        for (int i = tid; i < 24 * 1024; i += NTHR) { const int r = i >> 10, k = i & 1023; const float c = (r < 16) ? a.in[I_CP][r * 1024 + k] : a.in[I_CS][(r - 16) * 1024 + k]; A[i] = c / (1.f + __expf(-c)); }
        __syncthreads();
        for (int grp = bx; grp < 256; grp += G) {
            const int col = grp * 32;
            if (col < 6144) gemv24_group(A, red, a.in[I_WADA], 6144, col, a.in[I_BADA], mod, 6144, tid);
            else gemv24_group(A, red, a.in[I_WADAF], 2048, col - 6144, a.in[I_BADAF], modf, 2048, tid);
        }
        __syncthreads();
    }
    {
        LAS float* scr = (LAS float*)(lds + wave * 16384);
        constexpr int I_IN = 16 * 96, I_OUT = 16 * 32, I_UP = 16 * 128, I_DN = 64 * 32, NITEMS = I_IN + I_OUT + I_UP + I_DN;
        for (int it = gw; it < NITEMS; it += NGW) {
            int r = it;
            if (r < I_IN) { const int kb = r / 96, nb = r % 96; transpose_item(a.in[I_WIN], PROJ, 1024, Win_t, 64 * kb, 32 * nb + (nb >= 48 ? 8 : 0), 32 * nb, scr, lane); continue; } r -= I_IN;
            if (r < I_OUT) { const int kb = r / 32, nb = r % 32; transpose_item(a.in[I_WOUT], 1024, 1024, Wout_t, 64 * kb, 32 * nb, 32 * nb, scr, lane); continue; } r -= I_OUT;
            if (r < I_UP) { const int kb = r / 128, nb = r % 128; transpose_item(a.in[I_WUP], 4096, 1024, Wup_t, 64 * kb, 32 * nb, 32 * nb, scr, lane); continue; } r -= I_UP;
            { const int kb = r / 32, nb = r % 32; transpose_item(a.in[I_WDN], 1024, 4096, Wdn_t, 64 * kb, 32 * nb, 32 * nb, scr, lane); }
        }
    }
    grid.sync();
    {
        LAS float* WfT = (LAS float*)lds;
        for (int i = tid; i < 8192; i += NTHR) { const int hh = i & 7, k = i >> 3; WfT[hh * 1024 + k] = a.in[I_WIN][(size_t)k * PROJ + 1536 + hh]; }
        for (int i = bx * NTHR + tid; i < 24 * 1024; i += G * NTHR) { const int r = i >> 10, k = i & 1023; gm2[i] = a.in[I_G2][k] * (1.f + mod[(size_t)r * 6144 + 4096 + k]); }
        __syncthreads();
        f32x4 g1v[4];
#pragma unroll
        for (int j = 0; j < 4; ++j) g1v[j] = ((const f32x4*)a.in[I_G1])[lane + 64 * j];
        for (int row = gw; row < MPAD; row += NGW) {
            u32x2* xo = (u32x2*)(XN + (size_t)row * 1024) + lane;
            if (row >= MP + MS) {
#pragma unroll
                for (int j = 0; j < 4; ++j) xo[64 * j] = (u32x2){0u, 0u};
                continue;
            }
            const float* xr = (row < MP) ? a.in[I_XP] + (size_t)row * 1024 : a.in[I_XS] + (size_t)(row - MP) * 1024;
            const int mr = (row < MP) ? (row >> 12) : 16 + ((row - MP) >> 4);
            const f32x4* x4 = (const f32x4*)xr + lane; const f32x4* sh4 = (const f32x4*)(mod + (size_t)mr * 6144) + lane; const f32x4* sc4 = (const f32x4*)(mod + (size_t)mr * 6144 + 1024) + lane;
            f32x4 v[4]; float ss = 0.f;
#pragma unroll
            for (int j = 0; j < 4; ++j) { v[j] = x4[64 * j]; ss += (v[j][0] * v[j][0] + v[j][1] * v[j][1]) + (v[j][2] * v[j][2] + v[j][3] * v[j][3]); }
            const float rstd = 1.0f / sqrtf(wave_sum(ss) * (1.0f / 1024.0f) + NORM_EPS);
            float fl[8];
#pragma unroll
            for (int hh = 0; hh < 8; ++hh) fl[hh] = 0.f;
#pragma unroll
            for (int j = 0; j < 4; ++j) {
                const f32x4 hv = (v[j] * rstd) * g1v[j] * (sc4[64 * j] + 1.0f) + sh4[64 * j];
                xo[64 * j] = (u32x2){pk2(hv[0], hv[1]), pk2(hv[2], hv[3])};
#pragma unroll
                for (int hh = 0; hh < 8; ++hh) { const f32x4 w = *(const LAS f32x4*)(WfT + hh * 1024 + 4 * lane + 256 * j); fl[hh] += (hv[0] * w[0] + hv[1] * w[1]) + (hv[2] * w[2] + hv[3] * w[3]); }
            }
            float z = 0.f;
#pragma unroll
            for (int hh = 0; hh < 8; ++hh) { const float t = wave_sum(fl[hh]); z = (lane == hh) ? t : z; }
            if (lane < 8) {
                z += a.in[I_BF][lane];
                const float lf = fminf(z, 0.f) - log1pf(__expf(-fabsf(z)));
                if (row < MP) a.out[O_LP + (size_t)row * 8 + lane] = lf; else a.out[O_LS + (size_t)(row - MP) * 8 + lane] = lf;
            }
        }
    }
    grid.sync();
    {
        for (int seq = bx; seq < 192; seq += G) scan_seq(seq, a, (LAS float*)lds);
        __syncthreads();
        for (int slab = vcu; slab < NIN / 16; slab += G) {
            const int n0 = slab * 16, fr = lane & 15, fq = lane >> 4;
            const f32x4 acc = thin_gemm(XN + (size_t)MP * 1024, 1024, Win_t, 1024, 0, 1024, n0, wave, lane);
            const int c = n0 + 4 * fq, t = c >> 9, cc = c & 511, row = 16 * wave + fr;
            const f32x4 v = acc * ((t == 0) ? QSCALE : 1.f);
            *(u32x2*)(QB + (size_t)t * BUF512 + (size_t)(MP + row) * 512 + cc) = (u32x2){pk2(v[0], v[1]), pk2(v[2], v[3])};
            if (t == 1) *(f32x4*)(a.out + O_KS + (size_t)row * 512 + cc) = v;
            if (t == 2) *(f32x4*)(a.out + O_VS + (size_t)row * 512 + cc) = v;
        }
        pg8::Gemm g{XN, Win_t, MP, NIN, 1024}; pg8::StaticOrder S; S.init(MP, NIN, G, bx);
        pg8::EpiIn E{QB, a.out};
        for (int rep_ = 0; rep_ < REP_GEMM; ++rep_) pg8::gemm_phase<pg8::EpiIn, pg8::StaticOrder, true, true>(lds, g, S, E);
    }
    grid.sync();
    {
        const bf16* Qp = QB; const bf16* Kp = QB + BUF512; const bf16* Vp = QB + 2 * BUF512;
        for (int u = vcu; u < 256; u += G) attn_sample_unit(u >> 5, (u >> 2) & 7, u & 3, a, (LAS char*)lds);
#ifndef REP_ATT
#define REP_ATT 1
#endif
        for (int rep_ = 0; rep_ < REP_ATT; ++rep_)
        for (int u = vcu; u < 2048; u += G) {
            const int c = u & 255, i = u >> 8; const int bh = c >> 1, par = c & 1;
            const int k = 7 - i;
            const int qb = par ? ((k & 1) ? 4 * (k >> 1) + 2 : 4 * (k >> 1) + 1) : ((k & 1) ? 4 * (k >> 1) + 3 : 4 * (k >> 1));
            att::attn_unit(bh >> 3, bh & 7, qb, Qp, Kp, Vp, A2, (const float*)(ws + WS_FS) + (size_t)bh * 4096, (LAS char*)lds);
        }
    }
    grid.sync();
    {
        {
            LAS float* A = (LAS float*)lds; LAS float* red = (LAS float*)(lds + 98304);
            if (bx < 128) {
                for (int i = tid; i < 24 * 1024; i += NTHR) { const int r = i >> 10, k = i & 1023; A[i] = mod[(size_t)r * 6144 + 3072 + k]; }
                __syncthreads();
                for (int grp = bx; grp < 128; grp += G) gemv24_group(A, red, a.in[I_WUP], 4096, grp * 32, nullptr, BU, 4096, tid);
            }
        }
        const bf16* Ob = A2; const bf16* BGb = QB + 3 * BUF512; const bf16* CGb = QB + 4 * BUF512; const bf16* Ub = QB + 5 * BUF512;
        bf16* MG = XN;
        const int c0 = 8 * lane;
        float gatt[8], gconv[8], w0[8], w1[8], w2[8];
#pragma unroll
        for (int j = 0; j < 8; ++j) { gatt[j] = a.in[I_GATT][c0 + j]; gconv[j] = a.in[I_GCONV][c0 + j]; w0[j] = a.in[I_WCONV][c0 + j]; w1[j] = a.in[I_WCONV][512 + c0 + j]; w2[j] = a.in[I_WCONV][1024 + c0 + j]; }
        for (int run = gw; run < 2048 + 8; run += NGW) {
            const bool smp = run >= 2048; const int bs = run - 2048;
            const int row0 = smp ? MP + bs * 16 : run * 32; const int nrows = smp ? 16 : 32;
            float um2[8], um1[8];
            if (smp) {
#pragma unroll
                for (int j = 0; j < 8; ++j) { um2[j] = a.in[I_CCONV][(size_t)(bs * 2) * 512 + c0 + j]; um1[j] = a.in[I_CCONV][(size_t)(bs * 2 + 1) * 512 + c0 + j]; }
            } else if ((row0 & 4095) == 0) {
#pragma unroll
                for (int j = 0; j < 8; ++j) { um2[j] = 0.f; um1[j] = 0.f; }
            } else {
                float ca[8], ua[8];
                unpack8(*(const u32x4*)(CGb + (size_t)(row0 - 2) * 512 + c0), ca); unpack8(*(const u32x4*)(Ub + (size_t)(row0 - 2) * 512 + c0), ua);
#pragma unroll
                for (int j = 0; j < 8; ++j) um2[j] = ca[j] * ua[j];
                unpack8(*(const u32x4*)(CGb + (size_t)(row0 - 1) * 512 + c0), ca); unpack8(*(const u32x4*)(Ub + (size_t)(row0 - 1) * 512 + c0), ua);
#pragma unroll
                for (int j = 0; j < 8; ++j) um1[j] = ca[j] * ua[j];
            }
            for (int rr = 0; rr < nrows; ++rr) {
                const int row = row0 + rr;
                float at[8];
                if (!smp) unpack8(*(const u32x4*)(Ob + (size_t)row * 512 + c0), at);
                else {
                    const int hh = lane >> 3, d0 = (lane & 7) * 8;
                    const float* pp = (const float*)(ws + WS_PART) + ((size_t)((bs * 8 + hh) * 4) * 16 + rr) * 66;
                    float M = -1e30f;
#pragma unroll
                    for (int sp = 0; sp < 4; ++sp) M = fmaxf(M, pp[(size_t)sp * 16 * 66 + 64]);
                    float L = 0.f;
#pragma unroll
                    for (int j = 0; j < 8; ++j) at[j] = 0.f;
#pragma unroll
                    for (int sp = 0; sp < 4; ++sp) { const float* q = pp + (size_t)sp * 16 * 66; const float f = __builtin_amdgcn_exp2f(q[64] - M); L += q[65] * f;
#pragma unroll
                        for (int j = 0; j < 8; ++j) at[j] += q[d0 + j] * f; }
                    const float rl = 1.0f / L;
#pragma unroll
                    for (int j = 0; j < 8; ++j) at[j] *= rl;
                }
                float ss = 0.f;
#pragma unroll
                for (int j = 0; j < 8; ++j) ss += at[j] * at[j];
                const float ra = 1.0f / sqrtf(wave_sum(ss) * (1.0f / 512.0f) + NORM_EPS);
#pragma unroll
                for (int j = 0; j < 8; ++j) at[j] = at[j] * ra * gatt[j];
                *(u32x4*)(MG + (size_t)row * 1024 + c0) = pack8f(at);
                float bgv[8], ca[8], ua[8], u8[8], y[8];
                unpack8(*(const u32x4*)(BGb + (size_t)row * 512 + c0), bgv); unpack8(*(const u32x4*)(CGb + (size_t)row * 512 + c0), ca); unpack8(*(const u32x4*)(Ub + (size_t)row * 512 + c0), ua);
                float s2 = 0.f;
#pragma unroll
                for (int j = 0; j < 8; ++j) { u8[j] = ca[j] * ua[j]; y[j] = bgv[j] * (w0[j] * um2[j] + w1[j] * um1[j] + w2[j] * u8[j]); s2 += y[j] * y[j]; }
                const float rc = 1.0f / sqrtf(wave_sum(s2) * (1.0f / 512.0f) + NORM_EPS);
#pragma unroll
                for (int j = 0; j < 8; ++j) y[j] = y[j] * rc * gconv[j];
                *(u32x4*)(MG + (size_t)row * 1024 + 512 + c0) = pack8f(y);
                if (!smp) { const int t = row & 4095; if (t >= 4094) { float* co = a.out + O_CP + (size_t)((row >> 12) * 2 + (t - 4094)) * 512 + c0;
#pragma unroll
                        for (int j = 0; j < 8; ++j) co[j] = u8[j]; } }
                else if (rr >= 14) { float* co = a.out + O_CS + (size_t)(bs * 2 + (rr - 14)) * 512 + c0;
#pragma unroll
                        for (int j = 0; j < 8; ++j) co[j] = u8[j]; }
#pragma unroll
                for (int j = 0; j < 8; ++j) { um2[j] = um1[j]; um1[j] = u8[j]; }
            }
        }
    }
    grid.sync();
    {
        for (int slab = vcu; slab < 64; slab += G) {
            const int n0 = slab * 16, fr = lane & 15, fq = lane >> 4;
            const f32x4 acc = thin_gemm(XN + (size_t)MP * 1024, 1024, Wout_t, 1024, 0, 1024, n0, wave, lane);
            const int c = n0 + 4 * fq, row = 16 * wave + fr, mr = 16 + wave;
            const f32x4 xv = *(const f32x4*)(a.in[I_XS] + (size_t)row * 1024 + c), gt = *(const f32x4*)(mod + (size_t)mr * 6144 + 2048 + c), gm = *(const f32x4*)(gm2 + (size_t)mr * 1024 + c);
            const f32x4 r0 = xv + gt * acc;
            *(f32x4*)(X1 + (size_t)(MP + row) * 1024 + c) = r0;
            const f32x4 am = r0 * gm;
            *(u32x2*)(A2 + (size_t)(MP + row) * 1024 + c) = (u32x2){pk2(am[0], am[1]), pk2(am[2], am[3])};
            float s = (r0[0] * r0[0] + r0[1] * r0[1]) + (r0[2] * r0[2] + r0[3] * r0[3]);
            s += __shfl_xor(s, 16); s += __shfl_xor(s, 32);
            if (fq == 0) SST[row * 64 + slab] = s;
        }
        pg8::Gemm g{XN, Wout_t, MP, 1024, 1024}; pg8::StaticOrder S; S.init(MP, 1024, G, bx);
        pg8::EpiOut E{a.in[I_XP], mod, gm2, X1, A2, SS};
        for (int rep_ = 0; rep_ < REP_GEMM; ++rep_) pg8::gemm_phase<pg8::EpiOut, pg8::StaticOrder, true, true>(lds, g, S, E);
    }
    grid.sync();
    {
        for (int slab = vcu; slab < 256; slab += G) {
            const int n0 = slab * 16, fr = lane & 15, fq = lane >> 4;
            const int row = 16 * wave + fr, mr = 16 + wave;
            const f32x4* sp = (const f32x4*)(SST + row * 64 + 16 * fq);
            const f32x4 s4 = (sp[0] + sp[1]) + (sp[2] + sp[3]);
            float s = (s4[0] + s4[1]) + (s4[2] + s4[3]);
            s += __shfl_xor(s, 16); s += __shfl_xor(s, 32);
            const float rstd = 1.0f / sqrtf(s * (1.0f / 1024.0f) + NORM_EPS);
            const f32x4 acc = thin_gemm(A2 + (size_t)MP * 1024, 1024, Wup_t, 1024, 0, 1024, n0, wave, lane);
            const int c = n0 + 4 * fq;
            f32x4 v = acc * rstd + *(const f32x4*)(BU + (size_t)mr * 4096 + c);
#pragma unroll
            for (int j = 0; j < 4; ++j) { const float q = fmaxf(v[j], 0.f); v[j] = q * q; }
            *(u32x2*)(Hb + (size_t)(MP + row) * 4096 + c) = (u32x2){pk2(v[0], v[1]), pk2(v[2], v[3])};
        }
        pg8::Gemm g{A2, Wup_t, MP, FFD, 1024}; pg8::StaticOrder S; S.init(MP, FFD, G, bx);
        pg8::EpiUp E{SS, BU, Hb, (LAS float*)(lds + RING_BYTES)};
        for (int rep_ = 0; rep_ < REP_GEMM; ++rep_) pg8::gemm_phase<pg8::EpiUp, pg8::StaticOrder, true, true>(lds, g, S, E);
    }
    grid.sync();
    {
        for (int slab = vcu; slab < 256; slab += G) {
            const int n0 = (slab & 63) * 16, ks = slab >> 6, fr = lane & 15, fq = lane >> 4;
            const f32x4 acc = thin_gemm(Hb + (size_t)MP * 4096, 4096, Wdn_t, 4096, ks * 1024, 1024, n0, wave, lane);
            const int c = n0 + 4 * fq, row = 16 * wave + fr, mr = 16 + wave;
            const f32x4 gt = *(const f32x4*)(mod + (size_t)mr * 6144 + 5120 + c);
            float* xo = X1 + (size_t)(MP + row) * 1024 + c;
#pragma unroll
            for (int j = 0; j < 4; ++j) atomicAdd(xo + j, gt[j] * acc[j]);
        }
        pg8::Gemm g{Hb, Wdn_t, MP, 1024, FFD}; pg8::StaticOrder S; S.init(MP, 1024, G, bx);
        pg8::EpiDown E{mod, X1};
        pg8::gemm_phase<pg8::EpiDown, pg8::StaticOrder, true, true>(lds, g, S, E);
    }
    grid.sync();
    {
        f32x4 gfv[4];
#pragma unroll
        for (int j = 0; j < 4; ++j) gfv[j] = ((const f32x4*)a.in[I_GF])[lane + 64 * j];
        for (int row = gw; row < MP + MS; row += NGW) {
            const int mr = (row < MP) ? (row >> 12) : 16 + ((row - MP) >> 4);
            const f32x4* x4 = (const f32x4*)(X1 + (size_t)row * 1024) + lane;
            const f32x4* sh4 = (const f32x4*)(modf + (size_t)mr * 2048) + lane; const f32x4* sc4 = (const f32x4*)(modf + (size_t)mr * 2048 + 1024) + lane;
            f32x4* yo = (f32x4*)((row < MP) ? a.out + O_YP + (size_t)row * 1024 : a.out + O_YS + (size_t)(row - MP) * 1024) + lane;
            f32x4 v[4]; float ss = 0.f;
#pragma unroll
            for (int j = 0; j < 4; ++j) { v[j] = x4[64 * j]; ss += (v[j][0] * v[j][0] + v[j][1] * v[j][1]) + (v[j][2] * v[j][2] + v[j][3] * v[j][3]); }
            const float rstd = 1.0f / sqrtf(wave_sum(ss) * (1.0f / 1024.0f) + NORM_EPS);
#pragma unroll
            for (int j = 0; j < 4; ++j) yo[64 * j] = (v[j] * rstd) * gfv[j] * (sc4[64 * j] + 1.0f) + sh4[64 * j];
        }
    }
}

extern "C" void kernel_launch(void* const* d_in, const int* in_sizes, int n_in, void* d_out, int out_size, void* d_ws, size_t ws_size, hipStream_t stream) {
    static int grid = 0;
    if (grid == 0) {
        if (n_in != 23 || ws_size < WS_END) { fprintf(stderr, "kernel_launch: expected 23 inputs and >= %zu bytes of workspace; got %d, %zu\n", (size_t)WS_END, n_in, ws_size); grid = -1; return; }
        int dev = 0, cus = 0, per_cu = 0;
        hipGetDevice(&dev); hipDeviceGetAttribute(&cus, hipDeviceAttributeMultiprocessorCount, dev);
        hipFuncSetAttribute((const void*)hymba_fwd, hipFuncAttributeMaxDynamicSharedMemorySize, LDS_BYTES);
        hipOccupancyMaxActiveBlocksPerMultiprocessor(&per_cu, (const void*)hymba_fwd, NTHR, LDS_BYTES);
        if (per_cu < 1) { fprintf(stderr, "kernel_launch: occupancy query says %d blocks per CU\n", per_cu); per_cu = 1; }
        if (per_cu > 1) per_cu = 1;
        grid = cus * per_cu;
        (void)hipGetLastError();
    }
    if (grid < 0) return;
    Args a{};
    for (int i = 0; i < 23; ++i) a.in[i] = (const float*)d_in[i];
    a.out = (float*)d_out; a.ws = (unsigned char*)d_ws;
    void* params[] = {&a};
    hipError_t e = hipLaunchCooperativeKernel((const void*)hymba_fwd, dim3(grid), dim3(NTHR), params, LDS_BYTES, stream);
    if (e != hipSuccess) fprintf(stderr, "cooperative launch failed: %s (grid %d)\n", hipGetErrorString(e), grid);
}
```

```cpp
#include <hip/hip_runtime.h>
#include <hip/hip_cooperative_groups.h>
#include <cstdio>
#include <cstdint>
#include <cmath>
namespace cg = cooperative_groups;

constexpr int MP = 65536;
constexpr int MS = 128;
constexpr int MPAD = 65792;
constexpr int DMODEL = 1024, FFD = 4096, NIN = 3072, PROJ = 3080;
constexpr float NORM_EPS = 1e-6f;
constexpr float LOG2E = 1.4426950408889634f;
constexpr float QSCALE = 0.125f * 1.4426950408889634f;
constexpr size_t O_YP = 0, O_YS = 67108864, O_KP = 67239936, O_VP = 100794368, O_LP = 134348800, O_CP = 134873088,
                 O_KS = 134889472, O_VS = 134955008, O_LS = 135020544, O_CS = 135021568;
constexpr size_t MiB = 1u << 20;
constexpr size_t WS_WIN = 0, WS_WOUT = 6 * MiB, WS_WUP = 8 * MiB, WS_WDN = 16 * MiB;
constexpr size_t WS_MOD = 24 * MiB, WS_MODF = 24 * MiB + 640 * 1024, WS_GM2 = 24 * MiB + 896 * 1024, WS_BU = 25 * MiB;
constexpr size_t WS_SST = 25 * MiB + 512 * 1024;
constexpr size_t WS_FS = 26 * MiB, WS_FSS = 28 * MiB, WS_PART = 30 * MiB, WS_SS = 32 * MiB;
constexpr size_t WS_R1 = 40 * MiB;
constexpr size_t R1_XN = WS_R1, R1_Q = WS_R1 + (size_t)MPAD * 2048;
constexpr size_t BUF512 = (size_t)MPAD * 512;
constexpr size_t WS_X1 = WS_R1 + 514 * MiB;
constexpr size_t WS_A2 = WS_X1 + 257 * MiB;
constexpr size_t WS_END = WS_A2 + 129 * MiB;
static_assert((size_t)MPAD * 8192 == 514 * MiB, "H size");

namespace pg8 {
#define PG8_LAS __attribute__((address_space(3)))
typedef unsigned short bf16_t;
typedef short bf16x8 __attribute__((ext_vector_type(8)));
typedef float f32x4 __attribute__((ext_vector_type(4)));
typedef unsigned u32x4 __attribute__((ext_vector_type(4)));
constexpr int BM = 256, BK = 64, HALF = 128, HTB = HALF * BK * 2  , STAGE_BYTES = 8 * HTB, NXCD = 8, WGM = 8;

__host__ __device__ __forceinline__ int lds_byte(int r, int c) { const int st = (r >> 4) * 2 + (c >> 5), rr = r & 15, cc = c & 31, ob = rr * 64 + cc * 2; return st * 1024 + (ob ^ (((ob >> 9) & 1) << 5)); }
__host__ __device__ __forceinline__ void stage_rc(int b, int& R, int& C) { const int st = b / 1024, sb = b % 1024, swz = sb ^ (((sb >> 9) & 1) << 5); R = (st >> 1) * 16 + swz / 64; C = (st & 1) * 32 + (swz % 64) / 2; }
__host__ __device__ __forceinline__ int perm32(int rho) { const int n = rho >> 4, i = rho & 15; return 8 * (i >> 2) + 4 * n + (i & 3); }

struct Unit { int pm, pn; };
struct Gemm { const bf16_t* A; const bf16_t* Bt; int M, N, K; };

struct StaticOrder {
    int nM, nN, nwg, G, c;
    __host__ __device__ void init(int M, int N, int G_, int c_) { nM = M / BM; nN = N / BM; nwg = nM * nN; G = G_; c = c_; }
    __host__ __device__ bool next(int i, Unit& u) const {
        const long L = (long)i * G + c; if (L >= nwg) return false;
        int wgid = (int)L; { const int q = nwg / NXCD, r = nwg % NXCD, xcd = wgid % NXCD, off = wgid / NXCD; wgid = (xcd < r ? xcd * (q + 1) : r * (q + 1) + (xcd - r) * q) + off; }
        const int nig = WGM * nN, gid = wgid / nig, fm = gid * WGM, gsz = (nM - fm) < WGM ? (nM - fm) : WGM;
        u.pm = fm + ((wgid % nig) % gsz); u.pn = (wgid % nig) / gsz; return true;
    }
    __device__ __forceinline__ void a_ready(const Unit&) const {}
    __device__ __forceinline__ void done(const Unit&) const {}
};

__device__ __forceinline__ unsigned cvt_pk_bf16(float lo, float hi) { unsigned r; asm volatile("v_cvt_pk_bf16_f32 %0, %1, %2" : "=v"(r) : "v"(lo), "v"(hi)); return r; }
typedef float f32x2 __attribute__((ext_vector_type(2)));
__device__ __forceinline__ u32x4 pack8(const f32x4 v0, const f32x4 v1) { u32x4 w; w.x = cvt_pk_bf16(v0[0], v0[1]); w.y = cvt_pk_bf16(v0[2], v0[3]); w.z = cvt_pk_bf16(v1[0], v1[1]); w.w = cvt_pk_bf16(v1[2], v1[3]); return w; }
__device__ __forceinline__ float sumsq4(const f32x4 v) { return (v[0] * v[0] + v[1] * v[1]) + (v[2] * v[2] + v[3] * v[3]); }

struct EpiIn {
    static constexpr bool PERM = true, AFTER_DRAIN = false;
    bf16_t* QB; float* out;
    __device__ __forceinline__ void operator()(const f32x4 (&acc)[2][2][4][2], const Unit& u, int wr, int wc, int fr, int fq) const {
        const int t = u.pn >> 1;
        bf16_t* base = QB + (size_t)t * BUF512;
        const int col0 = (u.pn & 1) * 256 + wc * 32 + 8 * fq;
        const float sc = (t == 0) ? QSCALE : 1.f;
        const bool kv = (t == 1 || t == 2);
        float* fp = out + (t == 1 ? O_KP : O_VP);
        const int row0 = u.pm * BM + wr * 64 + fr;
#pragma unroll
        for (int ai = 0; ai < 2; ++ai)
#pragma unroll
            for (int m = 0; m < 4; ++m) {
                const int row = row0 + ai * HALF + m * 16;
                bf16_t* rowp = base + (size_t)row * 512 + col0;
                float* fo = nullptr;
                if (kv) fo = fp + (size_t)row * 512 + col0;
#pragma unroll
                for (int bj = 0; bj < 2; ++bj) {
                    const f32x4 v0 = acc[ai][bj][m][0] * sc, v1 = acc[ai][bj][m][1] * sc;
                    *(u32x4*)(rowp + bj * HALF) = pack8(v0, v1);
                    if (fo) { *(f32x4*)(fo + bj * HALF) = v0; *(f32x4*)(fo + bj * HALF + 4) = v1; }
                }
            }
    }
};
struct EpiOut {
    static constexpr bool PERM = true, AFTER_DRAIN = false;
    const float* xp; const float* mod; const float* gm2; float* X1; bf16_t* A2; float* SS;
    __device__ __forceinline__ void operator()(const f32x4 (&acc)[2][2][4][2], const Unit& u, int wr, int wc, int fr, int fq) const {
        const int col0 = u.pn * BM + wc * 32 + 8 * fq;
        const int row0 = u.pm * BM + wr * 64 + fr;
        const int mr = u.pm >> 4;
        const float* gt = mod + (size_t)mr * 6144 + 2048 + col0; const float* gm = gm2 + (size_t)mr * 1024 + col0;
        f32x4 gtv[2][2], gmv[2][2];
#pragma unroll
        for (int bj = 0; bj < 2; ++bj) { gtv[bj][0] = *(const f32x4*)(gt + bj * HALF); gtv[bj][1] = *(const f32x4*)(gt + bj * HALF + 4); gmv[bj][0] = *(const f32x4*)(gm + bj * HALF); gmv[bj][1] = *(const f32x4*)(gm + bj * HALF + 4); }
#pragma unroll
        for (int ai = 0; ai < 2; ++ai)
#pragma unroll
            for (int m = 0; m < 4; ++m) {
                const int row = row0 + ai * HALF + m * 16;
                const float* xr = xp + (size_t)row * 1024 + col0;
                f32x4 xv[2][2];
#pragma unroll
                for (int bj = 0; bj < 2; ++bj) { xv[bj][0] = *(const f32x4*)(xr + bj * HALF); xv[bj][1] = *(const f32x4*)(xr + bj * HALF + 4); }
                float s = 0.f;
#pragma unroll
                for (int bj = 0; bj < 2; ++bj) {
                    const int c = col0 + bj * HALF;
                    const f32x4 r0 = xv[bj][0] + gtv[bj][0] * acc[ai][bj][m][0], r1 = xv[bj][1] + gtv[bj][1] * acc[ai][bj][m][1];
                    *(f32x4*)(X1 + (size_t)row * 1024 + c) = r0; *(f32x4*)(X1 + (size_t)row * 1024 + c + 4) = r1;
                    s += sumsq4(r0) + sumsq4(r1);
                    *(u32x4*)(A2 + (size_t)row * 1024 + c) = pack8(r0 * gmv[bj][0], r1 * gmv[bj][1]);
                }
                s += __shfl_xor(s, 16); s += __shfl_xor(s, 32);
                if (fq == 0) SS[(size_t)row * 16 + u.pn * 4 + wc] = s;
            }
    }
};
struct EpiUp {
    static constexpr bool PERM = true, AFTER_DRAIN = false;
    const float* SS; const float* BU; bf16_t* H; PG8_LAS float* rtab;
    __device__ __forceinline__ void operator()(const f32x4 (&acc)[2][2][4][2], const Unit& u, int wr, int wc, int fr, int fq) const {
        const int col0 = u.pn * BM + wc * 32 + 8 * fq;
        const int row0 = u.pm * BM + wr * 64 + fr;
        { const int t = (wr * 4 + wc) * 64 + fq * 16 + fr;
          if (t < 256) { const f32x4* sp = (const f32x4*)(SS + (size_t)(u.pm * BM + t) * 16); const f32x4 s4 = (sp[0] + sp[1]) + (sp[2] + sp[3]);
              rtab[t] = 1.0f / sqrtf(((s4[0] + s4[1]) + (s4[2] + s4[3])) * (1.0f / 1024.0f) + NORM_EPS); } }
        const float* bu = BU + (size_t)(u.pm >> 4) * 4096 + col0;
        f32x4 bv[2][2];
#pragma unroll
        for (int bj = 0; bj < 2; ++bj) { bv[bj][0] = *(const f32x4*)(bu + bj * HALF); bv[bj][1] = *(const f32x4*)(bu + bj * HALF + 4); }
        asm volatile("s_waitcnt lgkmcnt(0)" ::: "memory"); __builtin_amdgcn_s_barrier(); asm volatile("" ::: "memory");
#pragma unroll
        for (int ai = 0; ai < 2; ++ai)
#pragma unroll
            for (int m = 0; m < 4; ++m) {
                const int row = row0 + ai * HALF + m * 16;
                const float rstd = rtab[ai * HALF + wr * 64 + m * 16 + fr];
#pragma unroll
                for (int bj = 0; bj < 2; ++bj) {
                    const int c = col0 + bj * HALF;
                    f32x4 v0 = acc[ai][bj][m][0] * rstd + bv[bj][0], v1 = acc[ai][bj][m][1] * rstd + bv[bj][1];
#pragma unroll
                    for (int j = 0; j < 4; ++j) { const float a = fmaxf(v0[j], 0.f), b = fmaxf(v1[j], 0.f); v0[j] = a * a; v1[j] = b * b; }
                    *(u32x4*)(H + (size_t)row * 4096 + c) = pack8(v0, v1);
                }
            }
    }
};
struct EpiDown {
    static constexpr bool PERM = true, AFTER_DRAIN = false;
    const float* mod; float* X1;
    __device__ __forceinline__ void operator()(const f32x4 (&acc)[2][2][4][2], const Unit& u, int wr, int wc, int fr, int fq) const {
        const int col0 = u.pn * BM + wc * 32 + 8 * fq;
        const int row0 = u.pm * BM + wr * 64 + fr;
        const float* gt = mod + (size_t)(u.pm >> 4) * 6144 + 5120 + col0;
        f32x4 gtv[2][2];
#pragma unroll
        for (int bj = 0; bj < 2; ++bj) { gtv[bj][0] = *(const f32x4*)(gt + bj * HALF); gtv[bj][1] = *(const f32x4*)(gt + bj * HALF + 4); }
#pragma unroll
        for (int ai = 0; ai < 2; ++ai)
#pragma unroll
            for (int m = 0; m < 4; ++m) {
                float* xr = X1 + (size_t)(row0 + ai * HALF + m * 16) * 1024 + col0;
                f32x4 xv[2][2];
#pragma unroll
                for (int bj = 0; bj < 2; ++bj) { xv[bj][0] = *(const f32x4*)(xr + bj * HALF); xv[bj][1] = *(const f32x4*)(xr + bj * HALF + 4); }
#pragma unroll
                for (int bj = 0; bj < 2; ++bj) { *(f32x4*)(xr + bj * HALF) = xv[bj][0] + gtv[bj][0] * acc[ai][bj][m][0]; *(f32x4*)(xr + bj * HALF + 4) = xv[bj][1] + gtv[bj][1] * acc[ai][bj][m][1]; }
            }
    }
};

template <class Epi, class Sched, bool ALIGN_EPI = false, bool SP2 = false>
__device__ __forceinline__ void gemm_phase(PG8_LAS unsigned char* lds, const Gemm g, const Sched& S, const Epi& E) {
    int tid_ = threadIdx.x; asm volatile("" : "+v"(tid_));
    const int tid = tid_, wid = __builtin_amdgcn_readfirstlane(tid >> 6), lane = tid & 63, wr = wid >> 2, wc = wid & 3, fr = lane & 15, fq = lane >> 4;
    const int K = g.K, nt = K / BK;
    unsigned voffA[2], voffB[2];
#pragma unroll
    for (int i = 0; i < 2; ++i) { int R, C; stage_rc(tid * 16 + i * 8192, R, C); const int Rb = Epi::PERM ? ((R & ~31) + perm32(R & 31)) : R;
        voffA[i] = (unsigned)(R * K + C) * 2u; voffB[i] = (unsigned)(Rb * K + C) * 2u; }
    const size_t kstep = (size_t)(BK * 2);
    const size_t hstep = (size_t)HALF * K * 2;
    const size_t tstep = 2 * hstep;
    const unsigned ldsw = (unsigned)wid * 1024u;
    const int aoff = lds_byte(wr * 64 + fr, fq * 8), boff = lds_byte(wc * 32 + fr, fq * 8);
#define PG8_SA(b, h) (((b) * 2 + (h)) * HTB)
#define PG8_SB(b, h) ((4 + (b) * 2 + (h)) * HTB)
#define PG8_STAGE(bufoff, gbase, voff) do { _Pragma("unroll") for (int _i = 0; _i < 2; ++_i) \
        __builtin_amdgcn_global_load_lds((const unsigned*)((const char*)(gbase) + (voff)[_i]), (PG8_LAS unsigned*)(lds + (bufoff) + ldsw + _i * 8192), 16, 0, 0); } while (0)
#define PG8_LDA(dst, b, h) do { _Pragma("unroll") for (int m = 0; m < 4; ++m) _Pragma("unroll") for (int k = 0; k < 2; ++k) dst[m][k] = *(const PG8_LAS bf16x8*)(lds + PG8_SA(b, h) + aoff + m * 2048 + k * 1024); } while (0)
#define PG8_LDB(dst, b, h) do { _Pragma("unroll") for (int n = 0; n < 2; ++n) _Pragma("unroll") for (int k = 0; k < 2; ++k) dst[n][k] = *(const PG8_LAS bf16x8*)(lds + PG8_SB(b, h) + boff + n * 2048 + k * 1024); } while (0)
#define PG8_MMA(ai, bj, At, Bt) do { __builtin_amdgcn_s_setprio(1); _Pragma("unroll") for (int m = 0; m < 4; ++m) _Pragma("unroll") for (int n = 0; n < 2; ++n) _Pragma("unroll") for (int k = 0; k < 2; ++k) \
        acc[ai][bj][m][n] = __builtin_amdgcn_mfma_f32_16x16x32_bf16(Bt[n][k], At[m][k], acc[ai][bj][m][n], 0, 0, 0); __builtin_amdgcn_s_setprio(0); } while (0)
#define PG8_WAIT_V(n) asm volatile("s_waitcnt vmcnt(" #n ")" ::: "memory")
#define PG8_WAIT_L(n) asm volatile("s_waitcnt lgkmcnt(" #n ")" ::: "memory")
#define PG8_BAR __builtin_amdgcn_s_barrier()
#define PG8_SCHED __builtin_amdgcn_sched_barrier(0)
    Unit cur, nxt; int ui = 0;
    if (!S.next(0, cur)) return;
    f32x4 acc[2][2][4][2];
#pragma unroll
    for (int a = 0; a < 2; ++a)
#pragma unroll
        for (int b = 0; b < 2; ++b)
#pragma unroll
            for (int m = 0; m < 4; ++m)
#pragma unroll
                for (int n = 0; n < 2; ++n) acc[a][b][m][n] = (f32x4){0.f, 0.f, 0.f, 0.f};
    bf16x8 At[4][2], B0[2][2], B1[2][2];
    const char* cA = (const char*)g.A + (size_t)cur.pm * tstep; const char* cB = (const char*)g.Bt + (size_t)cur.pn * tstep;
    S.a_ready(cur);
    if constexpr (SP2) {
        PG8_STAGE(PG8_SB(0, 0), cB, voffB); PG8_STAGE(PG8_SB(0, 1), cB + hstep, voffB); PG8_STAGE(PG8_SA(0, 0), cA, voffA); PG8_STAGE(PG8_SA(0, 1), cA + hstep, voffA);
        if (wr == 1) PG8_BAR;
        PG8_WAIT_V(2); PG8_BAR;
        PG8_STAGE(PG8_SB(1, 0), cB + kstep, voffB); PG8_STAGE(PG8_SA(1, 0), cA + kstep, voffA); PG8_STAGE(PG8_SB(1, 1), cB + hstep + kstep, voffB);
        PG8_WAIT_V(6); PG8_BAR;
    } else {
        PG8_STAGE(PG8_SB(0, 0), cB, voffB); PG8_STAGE(PG8_SA(0, 0), cA, voffA); PG8_STAGE(PG8_SB(0, 1), cB + hstep, voffB); PG8_STAGE(PG8_SA(0, 1), cA + hstep, voffA);
        if (wr == 1) PG8_BAR;
        PG8_WAIT_V(4); PG8_BAR;
        PG8_STAGE(PG8_SB(1, 0), cB + kstep, voffB); PG8_STAGE(PG8_SA(1, 0), cA + kstep, voffA); PG8_STAGE(PG8_SB(1, 1), cB + hstep + kstep, voffB);
        PG8_WAIT_V(6); PG8_BAR;
    }
    for (;;) {
        const bool has_next = S.next(ui + 1, nxt);
        const char* nA = has_next ? (const char*)g.A + (size_t)nxt.pm * tstep : cA; const char* nB = has_next ? (const char*)g.Bt + (size_t)nxt.pn * tstep : cB;
        for (int t = 0; t < nt; t += 2) {
            const bool last = (t == nt - 2);
            const char* a1 = cA + (size_t)(t + 1) * kstep;
            const char* a2 = last ? nA : cA + (size_t)(t + 2) * kstep; const char* b2 = last ? nB : cB + (size_t)(t + 2) * kstep;
            const char* a3 = a2 + kstep; const char* b3 = b2 + kstep;
            if (last && has_next) S.a_ready(nxt);
            if constexpr (SP2) {
            PG8_LDB(B0, 0, 0); PG8_LDB(B1, 0, 1); PG8_SCHED; PG8_LDA(At, 0, 0); PG8_STAGE(PG8_SA(1, 1), a1 + hstep, voffA);
            PG8_WAIT_V(8); PG8_WAIT_L(0); PG8_BAR; PG8_MMA(0, 0, At, B0); PG8_MMA(0, 1, At, B1); PG8_BAR; PG8_SCHED;
            PG8_LDA(At, 0, 1); PG8_STAGE(PG8_SB(0, 0), b2, voffB); PG8_STAGE(PG8_SB(0, 1), b2 + hstep, voffB); PG8_STAGE(PG8_SA(0, 0), a2, voffA);
            PG8_WAIT_V(8); PG8_WAIT_L(0); PG8_BAR; PG8_MMA(1, 0, At, B0); PG8_MMA(1, 1, At, B1); PG8_BAR; PG8_SCHED;
            PG8_LDB(B0, 1, 0); PG8_LDB(B1, 1, 1); PG8_SCHED; PG8_LDA(At, 1, 0); PG8_STAGE(PG8_SA(0, 1), a2 + hstep, voffA);
            PG8_WAIT_V(8); PG8_WAIT_L(0); PG8_BAR; PG8_MMA(0, 0, At, B0); PG8_MMA(0, 1, At, B1); PG8_BAR; PG8_SCHED;
            PG8_LDA(At, 1, 1); PG8_STAGE(PG8_SB(1, 0), b3, voffB); PG8_STAGE(PG8_SB(1, 1), b3 + hstep, voffB); PG8_STAGE(PG8_SA(1, 0), a3, voffA);
            PG8_WAIT_V(8); PG8_WAIT_L(0); PG8_BAR; PG8_MMA(1, 0, At, B0); PG8_MMA(1, 1, At, B1); PG8_BAR; PG8_SCHED;
            } else {
            PG8_LDB(B0, 0, 0); PG8_SCHED; PG8_LDA(At, 0, 0); PG8_STAGE(PG8_SA(1, 1), a1 + hstep, voffA);
            PG8_WAIT_L(8); PG8_BAR; PG8_WAIT_L(0); PG8_MMA(0, 0, At, B0); PG8_BAR; PG8_SCHED;
            PG8_LDB(B1, 0, 1); PG8_STAGE(PG8_SB(0, 0), b2, voffB);
            PG8_BAR; PG8_WAIT_L(0); PG8_MMA(0, 1, At, B1); PG8_BAR;
            PG8_LDA(At, 0, 1); PG8_STAGE(PG8_SA(0, 0), a2, voffA);
            PG8_BAR; PG8_WAIT_L(0); PG8_MMA(1, 0, At, B0); PG8_BAR; PG8_SCHED;
            PG8_STAGE(PG8_SB(0, 1), b2 + hstep, voffB);
            PG8_WAIT_V(6); PG8_BAR; PG8_MMA(1, 1, At, B1); PG8_BAR;
            PG8_LDB(B0, 1, 0); PG8_SCHED; PG8_LDA(At, 1, 0); PG8_STAGE(PG8_SA(0, 1), a2 + hstep, voffA);
            PG8_WAIT_L(8); PG8_BAR; PG8_WAIT_L(0); PG8_MMA(0, 0, At, B0); PG8_BAR; PG8_SCHED;
            PG8_LDB(B1, 1, 1); PG8_STAGE(PG8_SB(1, 0), b3, voffB);
            PG8_BAR; PG8_WAIT_L(0); PG8_MMA(0, 1, At, B1); PG8_BAR;
            PG8_LDA(At, 1, 1); PG8_STAGE(PG8_SA(1, 0), a3, voffA);
            PG8_BAR; PG8_WAIT_L(0); PG8_MMA(1, 0, At, B0); PG8_BAR; PG8_SCHED;
            PG8_STAGE(PG8_SB(1, 1), b3 + hstep, voffB);
            PG8_WAIT_V(6); PG8_BAR; PG8_MMA(1, 1, At, B1); PG8_BAR;
            }
        }
        if constexpr (ALIGN_EPI) { if (wr == 0) PG8_BAR; }
        if constexpr (!Epi::AFTER_DRAIN) { E(acc, cur, wr, wc, fr, fq); S.done(cur); }
        if (!has_next) break;
#pragma unroll
        for (int a = 0; a < 2; ++a)
#pragma unroll
            for (int b = 0; b < 2; ++b)
#pragma unroll
                for (int m = 0; m < 4; ++m)
#pragma unroll
                    for (int n = 0; n < 2; ++n) acc[a][b][m][n] = (f32x4){0.f, 0.f, 0.f, 0.f};
        cur = nxt; cA = nA; cB = nB; ++ui;
        if constexpr (ALIGN_EPI) { if (wr == 1) PG8_BAR; }
    }
    PG8_WAIT_V(0);
    if constexpr (!ALIGN_EPI) { if (wr == 0) PG8_BAR; }
    PG8_BAR;
    if constexpr (Epi::AFTER_DRAIN) { E.fused(acc, cur, wr, wc, fr, fq, lds, wid, lane); S.done(cur); }
#undef PG8_SA
#undef PG8_SB
#undef PG8_STAGE
#undef PG8_LDA
#undef PG8_LDB
#undef PG8_MMA
#undef PG8_WAIT_V
#undef PG8_WAIT_L
#undef PG8_BAR
#undef PG8_SCHED
}
}

#define LAS __attribute__((address_space(3)))
typedef unsigned short bf16;
typedef float f32x4 __attribute__((ext_vector_type(4)));
typedef unsigned u32x4 __attribute__((ext_vector_type(4)));
typedef unsigned u32x2 __attribute__((ext_vector_type(2)));
typedef short bf16x8 __attribute__((ext_vector_type(8)));
typedef short s16x4 __attribute__((ext_vector_type(4)));
typedef float f32x16 __attribute__((ext_vector_type(16)));
#define LDS_WAIT() asm volatile("s_waitcnt lgkmcnt(0)" ::: "memory")
#define DPPF(v, ctrl) __int_as_float(__builtin_amdgcn_update_dpp(0, __float_as_int(v), ctrl, 0xF, 0xF, true))
__device__ __forceinline__ float wave_sum(float v) {
    v += DPPF(v, 0xB1); v += DPPF(v, 0x4E); v += DPPF(v, 0x141); v += DPPF(v, 0x140);
    { auto rr = __builtin_amdgcn_permlane16_swap(__float_as_uint(v), __float_as_uint(v), false, false); v = __uint_as_float(rr[0]) + __uint_as_float(rr[1]); }
    { auto rr = __builtin_amdgcn_permlane32_swap(__float_as_uint(v), __float_as_uint(v), false, false); v = __uint_as_float(rr[0]) + __uint_as_float(rr[1]); }
    return v;
}
__device__ __forceinline__ float wave_max(float v) {
    v = fmaxf(v, DPPF(v, 0xB1)); v = fmaxf(v, DPPF(v, 0x4E)); v = fmaxf(v, DPPF(v, 0x141)); v = fmaxf(v, DPPF(v, 0x140));
    { auto rr = __builtin_amdgcn_permlane16_swap(__float_as_uint(v), __float_as_uint(v), false, false); v = fmaxf(__uint_as_float(rr[0]), __uint_as_float(rr[1])); }
    { auto rr = __builtin_amdgcn_permlane32_swap(__float_as_uint(v), __float_as_uint(v), false, false); v = fmaxf(__uint_as_float(rr[0]), __uint_as_float(rr[1])); }
    return v;
}
__device__ __forceinline__ float bf2f(unsigned b) { return __uint_as_float(b << 16); }
__device__ __forceinline__ unsigned f2bf(float f) { unsigned u = __float_as_uint(f); return (u + 0x7fffu + ((u >> 16) & 1u)) >> 16; }
__device__ __forceinline__ unsigned pk2(float lo, float hi) { return pg8::cvt_pk_bf16(lo, hi); }
__device__ __forceinline__ void unpack8(const u32x4 w, float (&v)[8]) {
    v[0] = bf2f(w.x & 0xffffu); v[1] = __uint_as_float(w.x & 0xffff0000u); v[2] = bf2f(w.y & 0xffffu); v[3] = __uint_as_float(w.y & 0xffff0000u);
    v[4] = bf2f(w.z & 0xffffu); v[5] = __uint_as_float(w.z & 0xffff0000u); v[6] = bf2f(w.w & 0xffffu); v[7] = __uint_as_float(w.w & 0xffff0000u);
}
__device__ __forceinline__ u32x4 pack8f(const float (&v)[8]) { u32x4 w; w.x = pk2(v[0], v[1]); w.y = pk2(v[2], v[3]); w.z = pk2(v[4], v[5]); w.w = pk2(v[6], v[7]); return w; }

struct Args { const float* in[23]; float* out; unsigned char* ws; };
enum { I_XP = 0, I_XS, I_CK, I_CV, I_CLF, I_CCONV, I_CP, I_CS, I_WADA, I_BADA, I_G1, I_G2, I_WIN, I_BF, I_WCONV, I_GATT, I_GCONV, I_WOUT, I_WUP, I_WDN, I_WADAF, I_BADAF, I_GF };

constexpr int NWAVES = 8, NTHR = 512;
constexpr int RING_BYTES = 131072, LDS_BYTES = 147456;

__device__ __forceinline__ void gemv24_group(const LAS float* A, LAS float* red, const float* W, int pitch, int col0, const float* bias, float* out, int opitch, int tid) {
    const int c = tid & 31, kg = tid >> 5;
    float acc[24];
#pragma unroll
    for (int r = 0; r < 24; ++r) acc[r] = 0.f;
    const float* wp = W + (size_t)(kg * 64) * pitch + col0 + c;
    const LAS float* ap = A + kg * 64;
#pragma unroll 2
    for (int k4 = 0; k4 < 16; ++k4) {
        const float w0 = wp[0], w1 = wp[pitch], w2 = wp[2 * (size_t)pitch], w3 = wp[3 * (size_t)pitch]; wp += 4 * (size_t)pitch;
#pragma unroll
        for (int r = 0; r < 24; ++r) { const f32x4 a = *(const LAS f32x4*)(ap + r * 1024 + k4 * 4); acc[r] += (a[0] * w0 + a[1] * w1) + (a[2] * w2 + a[3] * w3); }
    }
#pragma unroll
    for (int r = 0; r < 24; ++r) acc[r] += __shfl_xor(acc[r], 32);
    const int wid = tid >> 6, lane = tid & 63;
    if (lane < 32) {
#pragma unroll
        for (int r = 0; r < 24; ++r) red[(wid * 24 + r) * 32 + c] = acc[r];
    }
    __syncthreads();
    for (int o = tid; o < 768; o += NTHR) {
        const int r = o >> 5, cc = o & 31; float s = 0.f;
#pragma unroll
        for (int w = 0; w < 8; ++w) s += red[(w * 24 + r) * 32 + cc];
        if (bias) s += bias[col0 + cc];
        out[(size_t)r * opitch + col0 + cc] = s;
    }
    __syncthreads();
}

__device__ __forceinline__ void transpose_item(const float* W, int pitch, int K, bf16* WT, int k0, int nsrc0, int ndst0, LAS float* scr, int lane) {
#pragma unroll 8
    for (int i = 0; i < 32; ++i) { const int kk = 2 * i + (lane >> 5); scr[kk * 33 + (lane & 31)] = W[(size_t)(k0 + kk) * pitch + nsrc0 + (lane & 31)]; }
    LDS_WAIT(); asm volatile("" ::: "memory");
    const int c = lane & 7;
#pragma unroll
    for (int j = 0; j < 4; ++j) { const int n = (lane >> 3) + 8 * j; const LAS float* s = scr + (8 * c) * 33 + n;
        u32x4 o; o.x = pk2(s[0 * 33], s[1 * 33]); o.y = pk2(s[2 * 33], s[3 * 33]); o.z = pk2(s[4 * 33], s[5 * 33]); o.w = pk2(s[6 * 33], s[7 * 33]);
        *(u32x4*)(WT + (size_t)(ndst0 + n) * K + k0 + 8 * c) = o; }
    LDS_WAIT(); asm volatile("" ::: "memory");
}

namespace att {
constexpr int SEQ = 4096, D = 64, DM = 512, QB = 256, QBLK = 32, KVBLK = 64, NW = 8;
constexpr int SLOTB = 8192;
constexpr int NSLOT = 3;
constexpr int LDS_K = 0, LDS_V = NSLOT * SLOTB, LDS_WS = 2 * NSLOT * SLOTB, LDS_OST = LDS_WS + 2048, LDS_F = LDS_OST + NW * 4096, LDS_END = LDS_F + 16384;
static_assert(LDS_END <= RING_BYTES, "attention LDS");
__device__ __forceinline__ int crow(int r, int hi) { return (r & 3) + 8 * (r >> 2) + 4 * hi; }
__device__ __forceinline__ void cmask(f32x16& p0, f32x16& p1, int jb, int qrel, int hi) {
    const float NEG = -INFINITY; const int kb = 64 * jb + 4 * hi;
#pragma unroll
    for (int r = 0; r < 16; ++r) { const int kv = kb + (r & 3) + 8 * (r >> 2); if (kv > qrel) p0[r] = NEG; if (kv + 32 > qrel) p1[r] = NEG; }
}
__device__ __forceinline__ void glds16(const void* gsrc, unsigned lds_dst) { unsigned keep;
    asm volatile("s_mov_b32 %0, m0\n\ts_mov_b32 m0, %2\n\ts_nop 0\n\tglobal_load_lds_dwordx4 %1, off\n\ts_mov_b32 m0, %0" : "=&s"(keep) : "v"(gsrc), "s"(lds_dst) : "memory"); }
__device__ __forceinline__ float max3f(float a, float b, float c) { return fmaxf(fmaxf(a, b), c); }
__device__ __forceinline__ float rowmax(const f32x16& p0, const f32x16& p1) {
    float a = max3f(p0[0], p0[1], p1[0]), b = max3f(p0[2], p0[3], p1[1]); a = max3f(a, p1[2], p1[3]);
#pragma unroll
    for (int r = 4; r < 16; r += 4) { a = max3f(a, p0[r], p0[r + 1]); b = max3f(b, p0[r + 2], p0[r + 3]); a = max3f(a, p1[r], p1[r + 1]); b = max3f(b, p1[r + 2], p1[r + 3]); }
    const float m = fmaxf(a, b);
    auto rr = __builtin_amdgcn_permlane32_swap(__float_as_uint(m), __float_as_uint(m), false, false);
    return fmaxf(__uint_as_float(rr[0]), __uint_as_float(rr[1]));
}
#define ATT_WAIT_BAR0() asm volatile("s_waitcnt vmcnt(0) lgkmcnt(0)\n\ts_barrier" ::: "memory")
__device__ __forceinline__ void qkt(f32x16& p0, f32x16& p1, const LAS char* Kslot, const bf16x8* qr, const f32x16& cin, int r32, int hi) {
    const LAS char* kb = Kslot + hi * 1024 + r32 * 16;
#pragma unroll
    for (int d0 = 0; d0 < 4; ++d0) {
        const bf16x8 b0 = *(const LAS bf16x8*)(kb + d0 * 2048);
        const bf16x8 b1 = *(const LAS bf16x8*)(kb + d0 * 2048 + 512);
        if (d0 == 0) { p0 = __builtin_amdgcn_mfma_f32_32x32x16_bf16(b0, qr[0], cin, 0, 0, 0); p1 = __builtin_amdgcn_mfma_f32_32x32x16_bf16(b1, qr[0], cin, 0, 0, 0); }
        else { p0 = __builtin_amdgcn_mfma_f32_32x32x16_bf16(b0, qr[d0], p0, 0, 0, 0); p1 = __builtin_amdgcn_mfma_f32_32x32x16_bf16(b1, qr[d0], p1, 0, 0, 0); }
    }
}
__device__ __forceinline__ void pv(f32x16* o, int vb, bf16x8 pa0, bf16x8 pa1, bf16x8 pa2, bf16x8 pa3) {
    s16x4 lo[2][4], hi[2][4];
#pragma unroll
    for (int d0 = 0; d0 < 2; ++d0)
#pragma unroll
        for (int ks = 0; ks < 4; ++ks) {
            asm volatile("ds_read_b64_tr_b16 %0,%1 offset:%c2" : "=&v"(lo[d0][ks]) : "v"(vb), "i"(d0 * 4096 + ks * 1024) : "memory");
            asm volatile("ds_read_b64_tr_b16 %0,%1 offset:%c2" : "=&v"(hi[d0][ks]) : "v"(vb), "i"(d0 * 4096 + ks * 1024 + 512) : "memory"); }
    asm volatile("s_waitcnt lgkmcnt(0)" ::: "memory"); __builtin_amdgcn_sched_barrier(0);
#define ATT_PK(d, k) (bf16x8){lo[d][k][0], lo[d][k][1], lo[d][k][2], lo[d][k][3], hi[d][k][0], hi[d][k][1], hi[d][k][2], hi[d][k][3]}
    o[0] = __builtin_amdgcn_mfma_f32_32x32x16_bf16(pa0, ATT_PK(0, 0), o[0], 0, 0, 0);
    o[1] = __builtin_amdgcn_mfma_f32_32x32x16_bf16(pa0, ATT_PK(1, 0), o[1], 0, 0, 0);
    o[0] = __builtin_amdgcn_mfma_f32_32x32x16_bf16(pa1, ATT_PK(0, 1), o[0], 0, 0, 0);
    o[1] = __builtin_amdgcn_mfma_f32_32x32x16_bf16(pa1, ATT_PK(1, 1), o[1], 0, 0, 0);
    o[0] = __builtin_amdgcn_mfma_f32_32x32x16_bf16(pa2, ATT_PK(0, 2), o[0], 0, 0, 0);
    o[1] = __builtin_amdgcn_mfma_f32_32x32x16_bf16(pa2, ATT_PK(1, 2), o[1], 0, 0, 0);
    o[0] = __builtin_amdgcn_mfma_f32_32x32x16_bf16(pa3, ATT_PK(0, 3), o[0], 0, 0, 0);
    o[1] = __builtin_amdgcn_mfma_f32_32x32x16_bf16(pa3, ATT_PK(1, 3), o[1], 0, 0, 0);
#undef ATT_PK
}
typedef short v4i16_t __attribute__((ext_vector_type(4)));
__device__ __forceinline__ s16x4 vtr(const LAS char* p) { return __builtin_bit_cast(s16x4, __builtin_amdgcn_ds_read_tr16_b64_v4i16((LAS v4i16_t*)p)); }
#define SGB(mask, n) __builtin_amdgcn_sched_group_barrier(mask, n, 0)
template <bool MASK, bool HASNEXT>
__device__ __forceinline__ void att_step(f32x16& p0, f32x16& p1, f32x16& n0, f32x16& n1, f32x16 (&o)[2], float& l_reg, float& mref, f32x16& cin, const bf16x8 (&qr)[4],
                                         const LAS char* Kn, const LAS char* Vc, const LAS float* Fn, int jbn, int qrel, int r32, int hi, float fqv, LAS float* wsf) {
    bf16x8 kf[8];
    if constexpr (HASNEXT) {
        const LAS char* kb = Kn + hi * 1024 + r32 * 16;
#pragma unroll
        for (int d0 = 0; d0 < 4; ++d0) { kf[2 * d0] = *(const LAS bf16x8*)(kb + d0 * 2048); kf[2 * d0 + 1] = *(const LAS bf16x8*)(kb + d0 * 2048 + 512); }
    }
    if constexpr (HASNEXT) {
        n0 = __builtin_amdgcn_mfma_f32_32x32x16_bf16(kf[0], qr[0], cin, 0, 0, 0); n1 = __builtin_amdgcn_mfma_f32_32x32x16_bf16(kf[1], qr[0], cin, 0, 0, 0);
#pragma unroll
        for (int d0 = 1; d0 < 4; ++d0) { n0 = __builtin_amdgcn_mfma_f32_32x32x16_bf16(kf[2 * d0], qr[d0], n0, 0, 0, 0); n1 = __builtin_amdgcn_mfma_f32_32x32x16_bf16(kf[2 * d0 + 1], qr[d0], n1, 0, 0, 0); }
    }
    float sacc = 0.f;
#pragma unroll
    for (int r = 0; r < 16; ++r) { p0[r] = __builtin_amdgcn_exp2f(p0[r]); p1[r] = __builtin_amdgcn_exp2f(p1[r]); }
#pragma unroll
    for (int r = 0; r < 16; ++r) sacc += p0[r] + p1[r];
    l_reg += sacc;
    u32x4 pw0, pw1, pw2, pw3;
    pw0 = (u32x4){pk2(p0[0], p0[1]), pk2(p0[2], p0[3]), pk2(p0[4], p0[5]), pk2(p0[6], p0[7])};
    pw1 = (u32x4){pk2(p0[8], p0[9]), pk2(p0[10], p0[11]), pk2(p0[12], p0[13]), pk2(p0[14], p0[15])};
    pw2 = (u32x4){pk2(p1[0], p1[1]), pk2(p1[2], p1[3]), pk2(p1[4], p1[5]), pk2(p1[6], p1[7])};
    pw3 = (u32x4){pk2(p1[8], p1[9]), pk2(p1[10], p1[11]), pk2(p1[12], p1[13]), pk2(p1[14], p1[15])};
    if constexpr (HASNEXT) {
#pragma unroll
        for (int i = 0; i < 8; ++i) { SGB(0x008, 1); SGB(0x400, 4); SGB(0x002, 6); }
    }
    __builtin_amdgcn_sched_barrier(0);
    s16x4 vlo[2][4], vhi[2][4];
#pragma unroll
    for (int d0 = 0; d0 < 2; ++d0)
#pragma unroll
        for (int ks = 0; ks < 4; ++ks) { vlo[d0][ks] = vtr(Vc + d0 * 4096 + ks * 1024); vhi[d0][ks] = vtr(Vc + d0 * 4096 + ks * 1024 + 512); }
    const bf16x8 pa[4] = {__builtin_bit_cast(bf16x8, pw0), __builtin_bit_cast(bf16x8, pw1), __builtin_bit_cast(bf16x8, pw2), __builtin_bit_cast(bf16x8, pw3)};
#define ATT_VF(d, k) (bf16x8){vlo[d][k][0], vlo[d][k][1], vlo[d][k][2], vlo[d][k][3], vhi[d][k][0], vhi[d][k][1], vhi[d][k][2], vhi[d][k][3]}
#pragma unroll
    for (int ks = 0; ks < 4; ++ks) {
        o[0] = __builtin_amdgcn_mfma_f32_32x32x16_bf16(pa[ks], ATT_VF(0, ks), o[0], 0, 0, 0);
        o[1] = __builtin_amdgcn_mfma_f32_32x32x16_bf16(pa[ks], ATT_VF(1, ks), o[1], 0, 0, 0);
    }
#undef ATT_VF
    float rm = 0.f;
    if constexpr (HASNEXT) {
#pragma unroll
        for (int g = 0; g < 4; ++g) {
            const f32x4 f0 = *(const LAS f32x4*)(Fn + 8 * g + 4 * hi), f1 = *(const LAS f32x4*)(Fn + 32 + 8 * g + 4 * hi);
#pragma unroll
            for (int j = 0; j < 4; ++j) { n0[4 * g + j] -= f0[j]; n1[4 * g + j] -= f1[j]; }
        }
        if constexpr (MASK) cmask(n0, n1, jbn, qrel, hi);
        rm = rowmax(n0, n1);
#pragma unroll
        for (int i = 0; i < 8; ++i) { SGB(0x008, 1); SGB(0x002, 8); }
    }
    __builtin_amdgcn_sched_barrier(0);
    if constexpr (HASNEXT) {
        if (__any(rm > 8.0f)) {
            const float dl = fmaxf(rm, 0.f);
            mref += dl;
#pragma unroll
            for (int r = 0; r < 16; ++r) { n0[r] -= dl; n1[r] -= dl; }
#pragma unroll
            for (int r = 0; r < 16; ++r) cin[r] = fqv - mref;
            const float f = __builtin_amdgcn_exp2f(-dl); l_reg *= f;
            if (hi == 0) wsf[r32] = f;
            LDS_WAIT();
#pragma unroll
            for (int r = 0; r < 16; ++r) { const float g = wsf[crow(r, hi)]; o[0][r] *= g; o[1][r] *= g; }
        }
    }
}
__device__ __forceinline__ void attn_unit(int b, int h, int qb, const bf16* Q, const bf16* __restrict__ K, const bf16* __restrict__ V, bf16* O, const float* __restrict__ F2g, LAS char* shm) {
    int tid_ = threadIdx.x; asm volatile("" : "+v"(tid_));
    const int tid = tid_, lane = tid & 63, r32 = lane & 31, hi = lane >> 5; const int wid = __builtin_amdgcn_readfirstlane(tid >> 6);
    const long rowbase = (long)b * SEQ; const int q0 = qb * QB;
    const bf16* Qw = Q + (rowbase + q0 + wid * QBLK) * DM + h * D;
    const bf16* Kh = K + rowbase * DM + h * D, *Vh = V + rowbase * DM + h * D;
    const unsigned lds0 = (unsigned)(uintptr_t)shm;
    LAS float* wsf = (LAS float*)(shm + LDS_WS) + wid * 64;
    LAS float* Fl = (LAS float*)(shm + LDS_F);
    const bf16* ksrc = Kh + (long)lane * DM + wid * 8;
    const bf16* vsrc = Vh + (long)(16 * (wid & 3) + (lane >> 2)) * DM + (wid >> 2) * 32 + (lane & 3) * 8;
    const unsigned kdst = lds0 + LDS_K + wid * 1024, vdst = lds0 + LDS_V + wid * 1024;
#define DMA_K(t, slot) glds16(ksrc + (long)(t) * KVBLK * DM, (unsigned)__builtin_amdgcn_readfirstlane(kdst + (slot)))
#define DMA_V(t, slot) glds16(vsrc + (long)(t) * KVBLK * DM, (unsigned)__builtin_amdgcn_readfirstlane(vdst + (slot)))
    const LAS char* Kb = (const LAS char*)(shm + LDS_K);
    const LAS char* vp0 = (const LAS char*)(shm + LDS_V) + ((lane >> 4) & 1) * 32 + (lane & 3) * 8 + (4 * hi + ((lane & 15) >> 2)) * 64;
    const int NT = (q0 + QB) / KVBLK;
    DMA_K(0, 0); DMA_V(0, 0); DMA_K(1, SLOTB); DMA_V(1, SLOTB); DMA_K(2, 2 * SLOTB);
    for (int i = tid; i < NT * 64; i += NTHR) Fl[i] = F2g[i];
    bf16x8 qr[4];
#pragma unroll
    for (int d0 = 0; d0 < 4; ++d0) qr[d0] = *reinterpret_cast<const bf16x8*>(&Qw[(long)r32 * DM + d0 * 16 + hi * 8]);
    const float fqv = F2g[q0 + wid * QBLK + r32];
    f32x16 cin;
#pragma unroll
    for (int r = 0; r < 16; ++r) cin[r] = fqv;
    float mref = 0.f, l_reg = 0.f; f32x16 o[2];
#pragma unroll
    for (int r = 0; r < 16; ++r) { o[0][r] = 0.f; o[1][r] = 0.f; }
    const int qrel = wid * QBLK + r32;
    ATT_WAIT_BAR0();
    f32x16 p0, p1;
    qkt(p0, p1, Kb, qr, cin, r32, hi);
#pragma unroll
    for (int g = 0; g < 4; ++g) {
        const f32x4 f0 = *(const LAS f32x4*)(Fl + 8 * g + 4 * hi), f1 = *(const LAS f32x4*)(Fl + 32 + 8 * g + 4 * hi);
#pragma unroll
        for (int j = 0; j < 4; ++j) { p0[4 * g + j] -= f0[j]; p1[4 * g + j] -= f1[j]; }
    }
    if (NT == 4) cmask(p0, p1, 0, qrel, hi);
    { const float rm = rowmax(p0, p1); mref = rm;
#pragma unroll
      for (int r = 0; r < 16; ++r) { p0[r] -= rm; p1[r] -= rm; cin[r] = fqv - mref; } }
    int sk = SLOTB, sv = 0;
#define ATT_TOP(t) do { if ((t) + 2 < NT) asm volatile("s_waitcnt vmcnt(2) lgkmcnt(0)\n\ts_barrier" ::: "memory"); \
        else if ((t) + 1 < NT) asm volatile("s_waitcnt vmcnt(1) lgkmcnt(0)\n\ts_barrier" ::: "memory"); else ATT_WAIT_BAR0(); \
        if ((t) + 3 < NT) DMA_K((t) + 3, sv); if ((t) + 2 < NT) DMA_V((t) + 2, (sv == 0 ? 2 * SLOTB : sv - SLOTB)); } while (0)
#define ATT_ROT() do { sk = (sk == 2 * SLOTB ? 0 : sk + SLOTB); sv = (sv == 2 * SLOTB ? 0 : sv + SLOTB); } while (0)
    int t = 0;
    f32x16 pb0, pb1;
    for (; t + 6 < NT; t += 2) {
        ATT_TOP(t);
        att_step<false, true>(p0, p1, pb0, pb1, o, l_reg, mref, cin, qr, Kb + sk, vp0 + sv, Fl + 64 * (t + 1), 0, qrel, r32, hi, fqv, wsf);
        ATT_ROT();
        ATT_TOP(t + 1);
        att_step<false, true>(pb0, pb1, p0, p1, o, l_reg, mref, cin, qr, Kb + sk, vp0 + sv, Fl + 64 * (t + 2), 0, qrel, r32, hi, fqv, wsf);
        ATT_ROT();
    }
    for (; t + 5 < NT; ++t) {
        ATT_TOP(t);
        att_step<false, true>(p0, p1, pb0, pb1, o, l_reg, mref, cin, qr, Kb + sk, vp0 + sv, Fl + 64 * (t + 1), 0, qrel, r32, hi, fqv, wsf);
        p0 = pb0; p1 = pb1;
        ATT_ROT();
    }
    for (; t + 1 < NT; ++t) {
        ATT_TOP(t);
        att_step<true, true>(p0, p1, pb0, pb1, o, l_reg, mref, cin, qr, Kb + sk, vp0 + sv, Fl + 64 * (t + 1), (t + 1) - (NT - 4), qrel, r32, hi, fqv, wsf);
        p0 = pb0; p1 = pb1;
        ATT_ROT();
    }
    ATT_TOP(t);
    att_step<false, false>(p0, p1, pb0, pb1, o, l_reg, mref, cin, qr, Kb + sk, vp0 + sv, Fl, 0, qrel, r32, hi, fqv, wsf);
#undef ATT_TOP
#undef ATT_ROT
    { auto rr = __builtin_amdgcn_permlane32_swap(__float_as_uint(l_reg), __float_as_uint(l_reg), false, false); l_reg = __uint_as_float(rr[0]) + __uint_as_float(rr[1]); }
    if (hi == 0) wsf[32 + r32] = l_reg; LDS_WAIT();
    float rli[16];
#pragma unroll
    for (int r = 0; r < 16; ++r) rli[r] = __builtin_amdgcn_rcpf(wsf[32 + crow(r, hi)]);
    bf16* Ow = O + (rowbase + q0 + wid * QBLK) * DM + h * D;
    { LAS bf16* stg = (LAS bf16*)(shm + LDS_OST) + wid * 2048;
#pragma unroll
      for (int r = 0; r < 16; ++r) { const int orow = crow(r, hi);
#pragma unroll
        for (int d0 = 0; d0 < 2; ++d0) stg[orow * 64 + d0 * 32 + r32] = (bf16)f2bf(o[d0][r] * rli[r]); }
      LDS_WAIT();
#pragma unroll
      for (int i = 0; i < 4; ++i) { const int row = i * 8 + (lane >> 3), ch = lane & 7; const u32x4 v = *(const LAS u32x4*)(stg + row * 64 + ch * 8); *(u32x4*)(Ow + (long)row * DM + ch * 8) = v; } }
    asm volatile("s_waitcnt vmcnt(0) lgkmcnt(0)\n\ts_barrier" ::: "memory");
#undef DMA_K
#undef DMA_V
}
}

__device__ __forceinline__ void attn_sample_unit(int b, int h, int sp, const Args& a, LAS char* shm) {
    const int tid = threadIdx.x, lane = tid & 63; const int wid = __builtin_amdgcn_readfirstlane(tid >> 6);
    LAS float* qs = (LAS float*)shm;
    LAS float* ps = (LAS float*)(shm + 4096) + wid * 1024;
    LAS float* red = (LAS float*)(shm + 4096 + 32768);
    const bf16* Qb = (const bf16*)(a.ws + R1_Q) + (size_t)(MP + 16 * b) * 512 + h * 64;
    for (int i = tid; i < 1024; i += NTHR) qs[i] = bf2f(Qb[(i >> 6) * 512 + (i & 63)]);
    const float* F = (const float*)(a.ws + WS_FSS) + (size_t)(b * 8 + h) * 4112;
    __syncthreads();
    float m[16], ll[16], o[16];
#pragma unroll
    for (int i = 0; i < 16; ++i) { m[i] = -1e30f; ll[i] = 0.f; o[i] = 0.f; }
    const int nch = (sp == 3 && wid == 0) ? 3 : 2;
    for (int ch = 0; ch < nch; ++ch) {
        int key0, nvalid; const float* kbase; const float* vbase;
        if (ch < 2) { key0 = 1024 * sp + 128 * wid + 64 * ch; nvalid = 64; const size_t off = ((size_t)(b * 4096 + key0) * 8 + h) * 64; kbase = a.in[I_CK] + off; vbase = a.in[I_CV] + off; }
        else { key0 = 4096; nvalid = 16; const size_t off = ((size_t)(b * 16) * 8 + h) * 64; kbase = a.out + O_KS + off; vbase = a.out + O_VS + off; }
        const bool valid = lane < nvalid; const int key = key0 + lane;
        const float* kp = kbase + (size_t)(valid ? lane : 0) * 512;
        float s[16];
#pragma unroll
        for (int i = 0; i < 16; ++i) s[i] = 0.f;
#pragma unroll 4
        for (int d4 = 0; d4 < 16; ++d4) {
            const f32x4 kk = *(const f32x4*)(kp + 4 * d4);
#pragma unroll
            for (int i = 0; i < 16; ++i) { const f32x4 q4 = *(const LAS f32x4*)(qs + i * 64 + 4 * d4); s[i] += (q4[0] * kk[0] + q4[1] * kk[1]) + (q4[2] * kk[2] + q4[3] * kk[3]); }
        }
        const float fk = F[valid ? key : 0];
#pragma unroll
        for (int i = 0; i < 16; ++i) {
            float sv = s[i] + (F[4096 + i] - fk);
            if (!valid || key > 4096 + i) sv = -INFINITY;
            const float cm = wave_max(sv), mn = fmaxf(m[i], cm), al = __builtin_amdgcn_exp2f(m[i] - mn), p = __builtin_amdgcn_exp2f(sv - mn);
            ll[i] = ll[i] * al + p; o[i] *= al; m[i] = mn; s[i] = p;
        }
#pragma unroll
        for (int i4 = 0; i4 < 4; ++i4) *(LAS f32x4*)(ps + lane * 16 + 4 * i4) = (f32x4){s[4 * i4], s[4 * i4 + 1], s[4 * i4 + 2], s[4 * i4 + 3]};
        LDS_WAIT();
#pragma unroll 8
        for (int k = 0; k < nvalid; ++k) {
            const float v = vbase[(size_t)k * 512 + lane];
#pragma unroll
            for (int i4 = 0; i4 < 4; ++i4) { const f32x4 p4 = *(const LAS f32x4*)(ps + k * 16 + 4 * i4);
                o[4 * i4] += p4[0] * v; o[4 * i4 + 1] += p4[1] * v; o[4 * i4 + 2] += p4[2] * v; o[4 * i4 + 3] += p4[3] * v; }
        }
        LDS_WAIT();
    }
#pragma unroll
    for (int i = 0; i < 16; ++i) ll[i] = wave_sum(ll[i]);
#pragma unroll
    for (int i = 0; i < 16; ++i) red[(wid * 16 + i) * 66 + lane] = o[i];
    if (lane == 0) {
#pragma unroll
        for (int i = 0; i < 16; ++i) { red[(wid * 16 + i) * 66 + 64] = m[i]; red[(wid * 16 + i) * 66 + 65] = ll[i]; }
    }
    __syncthreads();
    {
        const int i = tid >> 5, dd = tid & 31;
        float M = -1e30f;
#pragma unroll
        for (int w = 0; w < 8; ++w) M = fmaxf(M, red[(w * 16 + i) * 66 + 64]);
        float L = 0.f, O0 = 0.f, O1 = 0.f;
#pragma unroll
        for (int w = 0; w < 8; ++w) { const float f = __builtin_amdgcn_exp2f(red[(w * 16 + i) * 66 + 64] - M); L += red[(w * 16 + i) * 66 + 65] * f; O0 += red[(w * 16 + i) * 66 + dd] * f; O1 += red[(w * 16 + i) * 66 + dd + 32] * f; }
        float* pp = (float*)(a.ws + WS_PART) + ((size_t)((b * 8 + h) * 4 + sp) * 16 + i) * 66;
        pp[dd] = O0; pp[dd + 32] = O1; if (dd == 0) { pp[64] = M; pp[65] = L; }
    }
    __syncthreads();
}

__device__ __forceinline__ void scan_seq(int seq, const Args& a, LAS float* sm) {
    const int tid = threadIdx.x, lane = tid & 63, wid = tid >> 6;
    const bool smp = seq >= 128; const int s = smp ? seq - 128 : seq; const int b = s >> 3, h = s & 7;
    const float* src = smp ? a.in[I_CLF] + (size_t)(b * 4096) * 8 + h : a.out + O_LP + (size_t)(b * 4096) * 8 + h;
    float v[8]; float run = 0.f;
#pragma unroll
    for (int i = 0; i < 8; ++i) { run += src[(size_t)(tid * 8 + i) * 8]; v[i] = run; }
    float inc = run;
#pragma unroll
    for (int o = 1; o < 64; o <<= 1) { const float t = __shfl_up(inc, o); if (lane >= o) inc += t; }
    if (lane == 63) sm[wid] = inc;
    __syncthreads();
    float off = inc - run;
    for (int w = 0; w < wid; ++w) off += sm[w];
    float* dst = smp ? (float*)(a.ws + WS_FSS) + (size_t)s * 4112 : (float*)(a.ws + WS_FS) + (size_t)s * 4096;
#pragma unroll
    for (int i = 0; i < 8; ++i) dst[tid * 8 + i] = (off + v[i]) * LOG2E;
    if (smp && tid == NTHR - 1) {
        float r2 = off + v[7];
        for (int i = 0; i < 16; ++i) { r2 += a.out[O_LS + (size_t)(b * 16 + i) * 8 + h]; dst[4096 + i] = r2 * LOG2E; }
    }
    __syncthreads();
}

__device__ __forceinline__ f32x4 thin_gemm(const bf16* A, int lda, const bf16* Bt, int ldb, int kbeg, int klen, int n0, int wave, int lane) {
    const int fr = lane & 15, fq = lane >> 4;
    const bf16* ap = A + (size_t)(16 * wave + fr) * lda + kbeg + 8 * fq;
    const bf16* bp = Bt + (size_t)(n0 + fr) * ldb + kbeg + 8 * fq;
    f32x4 acc0 = {0.f, 0.f, 0.f, 0.f}, acc1 = {0.f, 0.f, 0.f, 0.f};
#pragma unroll 4
    for (int k = 0; k < klen; k += 64) {
        const bf16x8 a0 = *(const bf16x8*)(ap + k), b0 = *(const bf16x8*)(bp + k), a1 = *(const bf16x8*)(ap + k + 32), b1 = *(const bf16x8*)(bp + k + 32);
        acc0 = __builtin_amdgcn_mfma_f32_16x16x32_bf16(b0, a0, acc0, 0, 0, 0);
        acc1 = __builtin_amdgcn_mfma_f32_16x16x32_bf16(b1, a1, acc1, 0, 0, 0);
    }
    return acc0 + acc1;
}

#ifndef REP_GEMM
#define REP_GEMM 1
#endif
__global__ void __launch_bounds__(NTHR, 2) hymba_fwd(Args a) {
    extern __shared__ __attribute__((aligned(16))) unsigned char lds_raw[];
    LAS unsigned char* lds = (LAS unsigned char*)lds_raw;
    cg::grid_group grid = cg::this_grid();
    const int tid = threadIdx.x, lane = tid & 63; const int wave = __builtin_amdgcn_readfirstlane(tid >> 6);
    const int G = gridDim.x, bx = blockIdx.x;
    const int vcu = (G % 8 == 0) ? (bx % 8) * (G / 8) + bx / 8 : bx;
    const int gw = vcu * NWAVES + wave, NGW = G * NWAVES;
    unsigned char* ws = a.ws;
    float* mod = (float*)(ws + WS_MOD); float* modf = (float*)(ws + WS_MODF); float* gm2 = (float*)(ws + WS_GM2); float* BU = (float*)(ws + WS_BU);
    bf16* Win_t = (bf16*)(ws + WS_WIN); bf16* Wout_t = (bf16*)(ws + WS_WOUT); bf16* Wup_t = (bf16*)(ws + WS_WUP); bf16* Wdn_t = (bf16*)(ws + WS_WDN);
    bf16* XN = (bf16*)(ws + R1_XN); bf16* QB = (bf16*)(ws + R1_Q); bf16* Hb = (bf16*)(ws + WS_R1);
    float* SST = (float*)(ws + WS_SST);
    float* X1 = (float*)(ws + WS_X1); bf16* A2 = (bf16*)(ws + WS_A2); float* SS = (float*)(ws + WS_SS);

    {
        LAS float* A = (LAS float*)lds; LAS float* red = (LAS float*)(lds + 98304);
        for (int i = tid; i < 24 * 1024; i += NTHR) { const int r = i >> 10, k = i & 1023; const float c = (r < 16) ? a.in[I_CP][r * 1024 + k] : a.in[I_CS][(r - 16) * 1024 + k]; A[i] = c / (1.f + __expf(-c)); }
        __syncthreads();
        for (int grp = bx; grp < 256; grp += G) {
            const int col = grp * 32;
            if (col < 6144) gemv24_group(A, red, a.in[I_WADA], 6144, col, a.in[I_BADA], mod, 6144, tid);
            else gemv24_group(A, red, a.in[I_WADAF], 2048, col - 6144, a.in[I_BADAF], modf, 2048, tid);
        }
        __syncthreads();
    }
    {
        LAS float* scr = (LAS float*)(lds + wave * 16384);
        constexpr int I_IN = 16 * 96, I_OUT = 16 * 32, I_UP = 16 * 128, I_DN = 64 * 32, NITEMS = I_IN + I_OUT + I_UP + I_DN;
        for (int it = gw; it < NITEMS; it += NGW) {
            int r = it;
            if (r < I_IN) { const int kb = r / 96, nb = r % 96; transpose_item(a.in[I_WIN], PROJ, 1024, Win_t, 64 * kb, 32 * nb + (nb >= 48 ? 8 : 0), 32 * nb, scr, lane); continue; } r -= I_IN;
            if (r < I_OUT) { const int kb = r / 32, nb = r % 32; transpose_item(a.in[I_WOUT], 1024, 1024, Wout_t, 64 * kb, 32 * nb, 32 * nb, scr, lane); continue; } r -= I_OUT;
            if (r < I_UP) { const int kb = r / 128, nb = r % 128; transpose_item(a.in[I_WUP], 4096, 1024, Wup_t, 64 * kb, 32 * nb, 32 * nb, scr, lane); continue; } r -= I_UP;
            { const int kb = r / 32, nb = r % 32; transpose_item(a.in[I_WDN], 1024, 4096, Wdn_t, 64 * kb, 32 * nb, 32 * nb, scr, lane); }
        }
    }
    grid.sync();
    {
        LAS float* WfT = (LAS float*)lds;
        for (int i = tid; i < 8192; i += NTHR) { const int hh = i & 7, k = i >> 3; WfT[hh * 1024 + k] = a.in[I_WIN][(size_t)k * PROJ + 1536 + hh]; }
        for (int i = bx * NTHR + tid; i < 24 * 1024; i += G * NTHR) { const int r = i >> 10, k = i & 1023; gm2[i] = a.in[I_G2][k] * (1.f + mod[(size_t)r * 6144 + 4096 + k]); }
        __syncthreads();
        f32x4 g1v[4];
#pragma unroll
        for (int j = 0; j < 4; ++j) g1v[j] = ((const f32x4*)a.in[I_G1])[lane + 64 * j];
        for (int row = MP + MS + gw; row < MPAD; row += NGW) { u32x2* xo = (u32x2*)(XN + (size_t)row * 1024) + lane;
#pragma unroll
            for (int j = 0; j < 4; ++j) xo[64 * j] = (u32x2){0u, 0u}; }
        f32x4 cx[4], csc[4], csh[4];
#define P0C_LOAD(row_, X, SC, SH) do { const int r_ = (row_); const float* xr_ = (r_ < MP) ? a.in[I_XP] + (size_t)r_ * 1024 : a.in[I_XS] + (size_t)(r_ - MP) * 1024; \
            const int mr_ = (r_ < MP) ? (r_ >> 12) : 16 + ((r_ - MP) >> 4); const f32x4* x4_ = (const f32x4*)xr_ + lane; \
            const f32x4* sh4_ = (const f32x4*)(mod + (size_t)mr_ * 6144) + lane; const f32x4* sc4_ = (const f32x4*)(mod + (size_t)mr_ * 6144 + 1024) + lane; \
            _Pragma("unroll") for (int j = 0; j < 4; ++j) { X[j] = x4_[64 * j]; SC[j] = sc4_[64 * j]; SH[j] = sh4_[64 * j]; } } while (0)
        int row = gw;
        if (row < MP + MS) P0C_LOAD(row, cx, csc, csh);
        while (row < MP + MS) {
            const int nrow = row + NGW;
            f32x4 nx[4], nsc[4], nsh[4];
            if (nrow < MP + MS) P0C_LOAD(nrow, nx, nsc, nsh);
            u32x2* xo = (u32x2*)(XN + (size_t)row * 1024) + lane;
            float ss = 0.f;
#pragma unroll
            for (int j = 0; j < 4; ++j) ss += (cx[j][0] * cx[j][0] + cx[j][1] * cx[j][1]) + (cx[j][2] * cx[j][2] + cx[j][3] * cx[j][3]);
            const float rstd = 1.0f / sqrtf(wave_sum(ss) * (1.0f / 1024.0f) + NORM_EPS);
            float fl[8];
#pragma unroll
            for (int hh = 0; hh < 8; ++hh) fl[hh] = 0.f;
#pragma unroll
            for (int j = 0; j < 4; ++j) {
                const f32x4 hv = (cx[j] * rstd) * g1v[j] * (csc[j] + 1.0f) + csh[j];
                xo[64 * j] = (u32x2){pk2(hv[0], hv[1]), pk2(hv[2], hv[3])};
#pragma unroll
                for (int hh = 0; hh < 8; ++hh) { const f32x4 w = *(const LAS f32x4*)(WfT + hh * 1024 + 4 * lane + 256 * j); fl[hh] += (hv[0] * w[0] + hv[1] * w[1]) + (hv[2] * w[2] + hv[3] * w[3]); }
            }
            float z = 0.f;
#pragma unroll
            for (int hh = 0; hh < 8; ++hh) { const float t = wave_sum(fl[hh]); z = (lane == hh) ? t : z; }
            if (lane < 8) {
                z += a.in[I_BF][lane];
                const float lf = fminf(z, 0.f) - log1pf(__expf(-fabsf(z)));
                if (row < MP) a.out[O_LP + (size_t)row * 8 + lane] = lf; else a.out[O_LS + (size_t)(row - MP) * 8 + lane] = lf;
            }
#pragma unroll
            for (int j = 0; j < 4; ++j) { cx[j] = nx[j]; csc[j] = nsc[j]; csh[j] = nsh[j]; }
            row = nrow;
        }
#undef P0C_LOAD
    }
    grid.sync();
    {
        for (int seq = bx; seq < 192; seq += G) scan_seq(seq, a, (LAS float*)lds);
        __syncthreads();
        for (int slab = vcu; slab < NIN / 16; slab += G) {
            const int n0 = slab * 16, fr = lane & 15, fq = lane >> 4;
            const f32x4 acc = thin_gemm(XN + (size_t)MP * 1024, 1024, Win_t, 1024, 0, 1024, n0, wave, lane);
            const int c = n0 + 4 * fq, t = c >> 9, cc = c & 511, row = 16 * wave + fr;
            const f32x4 v = acc * ((t == 0) ? QSCALE : 1.f);
            *(u32x2*)(QB + (size_t)t * BUF512 + (size_t)(MP + row) * 512 + cc) = (u32x2){pk2(v[0], v[1]), pk2(v[2], v[3])};
            if (t == 1) *(f32x4*)(a.out + O_KS + (size_t)row * 512 + cc) = v;
            if (t == 2) *(f32x4*)(a.out + O_VS + (size_t)row * 512 + cc) = v;
        }
        pg8::Gemm g{XN, Win_t, MP, NIN, 1024}; pg8::StaticOrder S; S.init(MP, NIN, G, bx);
        pg8::EpiIn E{QB, a.out};
        for (int rep_ = 0; rep_ < REP_GEMM; ++rep_) pg8::gemm_phase<pg8::EpiIn, pg8::StaticOrder, true, true>(lds, g, S, E);
    }
    grid.sync();
    {
        const bf16* Qp = QB; const bf16* Kp = QB + BUF512; const bf16* Vp = QB + 2 * BUF512;
        for (int u = vcu; u < 256; u += G) attn_sample_unit(u >> 5, (u >> 2) & 7, u & 3, a, (LAS char*)lds);
#ifndef REP_ATT
#define REP_ATT 1
#endif
        for (int rep_ = 0; rep_ < REP_ATT; ++rep_)
        for (int u = vcu; u < 2048; u += G) {
            const int c = u & 255, i = u >> 8; const int bh = c >> 1, par = c & 1;
            const int k = 7 - i;
            const int qb = par ? ((k & 1) ? 4 * (k >> 1) + 2 : 4 * (k >> 1) + 1) : ((k & 1) ? 4 * (k >> 1) + 3 : 4 * (k >> 1));
            att::attn_unit(bh >> 3, bh & 7, qb, Qp, Kp, Vp, A2, (const float*)(ws + WS_FS) + (size_t)bh * 4096, (LAS char*)lds);
        }
    }
    grid.sync();
    {
        {
            LAS float* A = (LAS float*)lds; LAS float* red = (LAS float*)(lds + 98304);
            if (bx < 128) {
                for (int i = tid; i < 24 * 1024; i += NTHR) { const int r = i >> 10, k = i & 1023; A[i] = mod[(size_t)r * 6144 + 3072 + k]; }
                __syncthreads();
                for (int grp = bx; grp < 128; grp += G) gemv24_group(A, red, a.in[I_WUP], 4096, grp * 32, nullptr, BU, 4096, tid);
            }
        }
        const bf16* Ob = A2; const bf16* BGb = QB + 3 * BUF512; const bf16* CGb = QB + 4 * BUF512; const bf16* Ub = QB + 5 * BUF512;
        bf16* MG = XN;
        const int c0 = 8 * lane;
        float gatt[8], gconv[8], w0[8], w1[8], w2[8];
#pragma unroll
        for (int j = 0; j < 8; ++j) { gatt[j] = a.in[I_GATT][c0 + j]; gconv[j] = a.in[I_GCONV][c0 + j]; w0[j] = a.in[I_WCONV][c0 + j]; w1[j] = a.in[I_WCONV][512 + c0 + j]; w2[j] = a.in[I_WCONV][1024 + c0 + j]; }
        for (int run = gw; run < 2048 + 8; run += NGW) {
            const bool smp = run >= 2048; const int bs = run - 2048;
            const int row0 = smp ? MP + bs * 16 : run * 32; const int nrows = smp ? 16 : 32;
            float um2[8], um1[8];
            if (smp) {
#pragma unroll
                for (int j = 0; j < 8; ++j) { um2[j] = a.in[I_CCONV][(size_t)(bs * 2) * 512 + c0 + j]; um1[j] = a.in[I_CCONV][(size_t)(bs * 2 + 1) * 512 + c0 + j]; }
            } else if ((row0 & 4095) == 0) {
#pragma unroll
                for (int j = 0; j < 8; ++j) { um2[j] = 0.f; um1[j] = 0.f; }
            } else {
                float ca[8], ua[8];
                unpack8(*(const u32x4*)(CGb + (size_t)(row0 - 2) * 512 + c0), ca); unpack8(*(const u32x4*)(Ub + (size_t)(row0 - 2) * 512 + c0), ua);
#pragma unroll
                for (int j = 0; j < 8; ++j) um2[j] = ca[j] * ua[j];
                unpack8(*(const u32x4*)(CGb + (size_t)(row0 - 1) * 512 + c0), ca); unpack8(*(const u32x4*)(Ub + (size_t)(row0 - 1) * 512 + c0), ua);
#pragma unroll
                for (int j = 0; j < 8; ++j) um1[j] = ca[j] * ua[j];
            }
            u32x4 cO, cB, cC, cU;
            cO = smp ? (u32x4){0u, 0u, 0u, 0u} : *(const u32x4*)(Ob + (size_t)row0 * 512 + c0);
            cB = *(const u32x4*)(BGb + (size_t)row0 * 512 + c0); cC = *(const u32x4*)(CGb + (size_t)row0 * 512 + c0); cU = *(const u32x4*)(Ub + (size_t)row0 * 512 + c0);
            for (int rr = 0; rr < nrows; ++rr) {
                const int row = row0 + rr;
                u32x4 nO = cO, nB = cB, nC = cC, nU = cU;
                if (rr + 1 < nrows) {
                    if (!smp) nO = *(const u32x4*)(Ob + (size_t)(row + 1) * 512 + c0);
                    nB = *(const u32x4*)(BGb + (size_t)(row + 1) * 512 + c0); nC = *(const u32x4*)(CGb + (size_t)(row + 1) * 512 + c0); nU = *(const u32x4*)(Ub + (size_t)(row + 1) * 512 + c0);
                }
                float at[8];
                if (!smp) unpack8(cO, at);
                else {
                    const int hh = lane >> 3, d0 = (lane & 7) * 8;
                    const float* pp = (const float*)(ws + WS_PART) + ((size_t)((bs * 8 + hh) * 4) * 16 + rr) * 66;
                    float M = -1e30f;
#pragma unroll
                    for (int sp = 0; sp < 4; ++sp) M = fmaxf(M, pp[(size_t)sp * 16 * 66 + 64]);
                    float L = 0.f;
#pragma unroll
                    for (int j = 0; j < 8; ++j) at[j] = 0.f;
#pragma unroll
                    for (int sp = 0; sp < 4; ++sp) { const float* q = pp + (size_t)sp * 16 * 66; const float f = __builtin_amdgcn_exp2f(q[64] - M); L += q[65] * f;
#pragma unroll
                        for (int j = 0; j < 8; ++j) at[j] += q[d0 + j] * f; }
                    const float rl = 1.0f / L;
#pragma unroll
                    for (int j = 0; j < 8; ++j) at[j] *= rl;
                }
                float ss = 0.f;
#pragma unroll
                for (int j = 0; j < 8; ++j) ss += at[j] * at[j];
                const float ra = 1.0f / sqrtf(wave_sum(ss) * (1.0f / 512.0f) + NORM_EPS);
#pragma unroll
                for (int j = 0; j < 8; ++j) at[j] = at[j] * ra * gatt[j];
                *(u32x4*)(MG + (size_t)row * 1024 + c0) = pack8f(at);
                float bgv[8], ca[8], ua[8], u8[8], y[8];
                unpack8(cB, bgv); unpack8(cC, ca); unpack8(cU, ua);
                float s2 = 0.f;
#pragma unroll
                for (int j = 0; j < 8; ++j) { u8[j] = ca[j] * ua[j]; y[j] = bgv[j] * (w0[j] * um2[j] + w1[j] * um1[j] + w2[j] * u8[j]); s2 += y[j] * y[j]; }
                const float rc = 1.0f / sqrtf(wave_sum(s2) * (1.0f / 512.0f) + NORM_EPS);
#pragma unroll
                for (int j = 0; j < 8; ++j) y[j] = y[j] * rc * gconv[j];
                *(u32x4*)(MG + (size_t)row * 1024 + 512 + c0) = pack8f(y);
                if (!smp) { const int t = row & 4095; if (t >= 4094) { float* co = a.out + O_CP + (size_t)((row >> 12) * 2 + (t - 4094)) * 512 + c0;
#pragma unroll
                        for (int j = 0; j < 8; ++j) co[j] = u8[j]; } }
                else if (rr >= 14) { float* co = a.out + O_CS + (size_t)(bs * 2 + (rr - 14)) * 512 + c0;
#pragma unroll
                        for (int j = 0; j < 8; ++j) co[j] = u8[j]; }
#pragma unroll
                for (int j = 0; j < 8; ++j) { um2[j] = um1[j]; um1[j] = u8[j]; }
                cO = nO; cB = nB; cC = nC; cU = nU;
            }
        }
    }
    grid.sync();
    {
        for (int slab = vcu; slab < 64; slab += G) {
            const int n0 = slab * 16, fr = lane & 15, fq = lane >> 4;
            const f32x4 acc = thin_gemm(XN + (size_t)MP * 1024, 1024, Wout_t, 1024, 0, 1024, n0, wave, lane);
            const int c = n0 + 4 * fq, row = 16 * wave + fr, mr = 16 + wave;
            const f32x4 xv = *(const f32x4*)(a.in[I_XS] + (size_t)row * 1024 + c), gt = *(const f32x4*)(mod + (size_t)mr * 6144 + 2048 + c), gm = *(const f32x4*)(gm2 + (size_t)mr * 1024 + c);
            const f32x4 r0 = xv + gt * acc;
            *(f32x4*)(X1 + (size_t)(MP + row) * 1024 + c) = r0;
            const f32x4 am = r0 * gm;
            *(u32x2*)(A2 + (size_t)(MP + row) * 1024 + c) = (u32x2){pk2(am[0], am[1]), pk2(am[2], am[3])};
            float s = (r0[0] * r0[0] + r0[1] * r0[1]) + (r0[2] * r0[2] + r0[3] * r0[3]);
            s += __shfl_xor(s, 16); s += __shfl_xor(s, 32);
            if (fq == 0) SST[row * 64 + slab] = s;
        }
        pg8::Gemm g{XN, Wout_t, MP, 1024, 1024}; pg8::StaticOrder S; S.init(MP, 1024, G, bx);
        pg8::EpiOut E{a.in[I_XP], mod, gm2, X1, A2, SS};
        for (int rep_ = 0; rep_ < REP_GEMM; ++rep_) pg8::gemm_phase<pg8::EpiOut, pg8::StaticOrder, true, true>(lds, g, S, E);
    }
    grid.sync();
    {
        for (int slab = vcu; slab < 256; slab += G) {
            const int n0 = slab * 16, fr = lane & 15, fq = lane >> 4;
            const int row = 16 * wave + fr, mr = 16 + wave;
            const f32x4* sp = (const f32x4*)(SST + row * 64 + 16 * fq);
            const f32x4 s4 = (sp[0] + sp[1]) + (sp[2] + sp[3]);
            float s = (s4[0] + s4[1]) + (s4[2] + s4[3]);
            s += __shfl_xor(s, 16); s += __shfl_xor(s, 32);
            const float rstd = 1.0f / sqrtf(s * (1.0f / 1024.0f) + NORM_EPS);
            const f32x4 acc = thin_gemm(A2 + (size_t)MP * 1024, 1024, Wup_t, 1024, 0, 1024, n0, wave, lane);
            const int c = n0 + 4 * fq;
            f32x4 v = acc * rstd + *(const f32x4*)(BU + (size_t)mr * 4096 + c);
#pragma unroll
            for (int j = 0; j < 4; ++j) { const float q = fmaxf(v[j], 0.f); v[j] = q * q; }
            *(u32x2*)(Hb + (size_t)(MP + row) * 4096 + c) = (u32x2){pk2(v[0], v[1]), pk2(v[2], v[3])};
        }
        pg8::Gemm g{A2, Wup_t, MP, FFD, 1024}; pg8::StaticOrder S; S.init(MP, FFD, G, bx);
        pg8::EpiUp E{SS, BU, Hb, (LAS float*)(lds + RING_BYTES)};
        for (int rep_ = 0; rep_ < REP_GEMM; ++rep_) pg8::gemm_phase<pg8::EpiUp, pg8::StaticOrder, true, true>(lds, g, S, E);
    }
    grid.sync();
    {
        for (int slab = vcu; slab < 256; slab += G) {
            const int n0 = (slab & 63) * 16, ks = slab >> 6, fr = lane & 15, fq = lane >> 4;
            const f32x4 acc = thin_gemm(Hb + (size_t)MP * 4096, 4096, Wdn_t, 4096, ks * 1024, 1024, n0, wave, lane);
            const int c = n0 + 4 * fq, row = 16 * wave + fr, mr = 16 + wave;
            const f32x4 gt = *(const f32x4*)(mod + (size_t)mr * 6144 + 5120 + c);
            float* xo = X1 + (size_t)(MP + row) * 1024 + c;
#pragma unroll
            for (int j = 0; j < 4; ++j) atomicAdd(xo + j, gt[j] * acc[j]);
        }
        pg8::Gemm g{Hb, Wdn_t, MP, 1024, FFD}; pg8::StaticOrder S; S.init(MP, 1024, G, bx);
        pg8::EpiDown E{mod, X1};
        pg8::gemm_phase<pg8::EpiDown, pg8::StaticOrder, true, true>(lds, g, S, E);
    }
    grid.sync();
    {
        f32x4 gfv[4];
#pragma unroll
        for (int j = 0; j < 4; ++j) gfv[j] = ((const f32x4*)a.in[I_GF])[lane + 64 * j];
        f32x4 cx[4], csc[4], csh[4];
#define P7_LOAD(row_, X, SC, SH) do { const int r_ = (row_); const int mr_ = (r_ < MP) ? (r_ >> 12) : 16 + ((r_ - MP) >> 4); const f32x4* x4_ = (const f32x4*)(X1 + (size_t)r_ * 1024) + lane; \
            const f32x4* sh4_ = (const f32x4*)(modf + (size_t)mr_ * 2048) + lane; const f32x4* sc4_ = (const f32x4*)(modf + (size_t)mr_ * 2048 + 1024) + lane; \
            _Pragma("unroll") for (int j = 0; j < 4; ++j) { X[j] = x4_[64 * j]; SC[j] = sc4_[64 * j]; SH[j] = sh4_[64 * j]; } } while (0)
        int row = gw;
        if (row < MP + MS) P7_LOAD(row, cx, csc, csh);
        while (row < MP + MS) {
            const int nrow = row + NGW;
            f32x4 nx[4], nsc[4], nsh[4];
            if (nrow < MP + MS) P7_LOAD(nrow, nx, nsc, nsh);
            f32x4* yo = (f32x4*)((row < MP) ? a.out + O_YP + (size_t)row * 1024 : a.out + O_YS + (size_t)(row - MP) * 1024) + lane;
            float ss = 0.f;
#pragma unroll
            for (int j = 0; j < 4; ++j) ss += (cx[j][0] * cx[j][0] + cx[j][1] * cx[j][1]) + (cx[j][2] * cx[j][2] + cx[j][3] * cx[j][3]);
            const float rstd = 1.0f / sqrtf(wave_sum(ss) * (1.0f / 1024.0f) + NORM_EPS);
#pragma unroll
            for (int j = 0; j < 4; ++j) yo[64 * j] = (cx[j] * rstd) * gfv[j] * (csc[j] + 1.0f) + csh[j];
#pragma unroll
            for (int j = 0; j < 4; ++j) { cx[j] = nx[j]; csc[j] = nsc[j]; csh[j] = nsh[j]; }
            row = nrow;
        }
#undef P7_LOAD
    }
}

extern "C" void kernel_launch(void* const* d_in, const int* in_sizes, int n_in, void* d_out, int out_size, void* d_ws, size_t ws_size, hipStream_t stream) {
    static int grid = 0;
    if (grid == 0) {
        if (n_in != 23 || ws_size < WS_END) { fprintf(stderr, "kernel_launch: expected 23 inputs and >= %zu bytes of workspace; got %d, %zu\n", (size_t)WS_END, n_in, ws_size); grid = -1; return; }
        int dev = 0, cus = 0, per_cu = 0;
        hipGetDevice(&dev); hipDeviceGetAttribute(&cus, hipDeviceAttributeMultiprocessorCount, dev);
        hipFuncSetAttribute((const void*)hymba_fwd, hipFuncAttributeMaxDynamicSharedMemorySize, LDS_BYTES);
        hipOccupancyMaxActiveBlocksPerMultiprocessor(&per_cu, (const void*)hymba_fwd, NTHR, LDS_BYTES);
        if (per_cu < 1) { fprintf(stderr, "kernel_launch: occupancy query says %d blocks per CU\n", per_cu); per_cu = 1; }
        if (per_cu > 1) per_cu = 1;
        grid = cus * per_cu;
        (void)hipGetLastError();
    }
    if (grid < 0) return;
    Args a{};
    for (int i = 0; i < 23; ++i) a.in[i] = (const float*)d_in[i];
    a.out = (float*)d_out; a.ws = (unsigned char*)d_ws;
    void* params[] = {&a};
    hipError_t e = hipLaunchCooperativeKernel((const void*)hymba_fwd, dim3(grid), dim3(NTHR), params, LDS_BYTES, stream);
    if (e != hipSuccess) fprintf(stderr, "cooperative launch failed: %s (grid %d)\n", hipGetErrorString(e), grid);
}
```
